# Optimizing an MI355X kernel written in HIP

```python
import jax
import jax.numpy as jnp
from jax import lax
import numpy as np

D_MODEL = 4096
BATCH = 2
SEQ = 4096
DEPTH = 2

GRID_W = 64
CTX_LEN = 256
DK_A = 128
DV_A = 128
N_HEADS_A = D_MODEL // (2 * DK_A)
WIDTH_A = N_HEADS_A * DK_A
WIDTH_B = D_MODEL // 2
CONV_W = 3
D_FF = 4 * D_MODEL
CHUNK = 64
A_COLS = 5 * WIDTH_A
A_STATE_COLS = 3 * WIDTH_A
B_COLS = 3 * WIDTH_B
G_COLS = 2 * D_MODEL
N_IN = A_COLS + B_COLS + G_COLS
N_MOD = 6 * D_MODEL
ALPHA = (2.0 * DEPTH) ** 0.25
BETA = (8.0 * DEPTH) ** -0.25
LN_EPS = 1e-5
RMS_EPS = 1e-6

kernel_name = "hgrn2_shortconv_parallel_dit_block"


def _heads(t):
    return t.reshape(t.shape[:-1] + (N_HEADS_A, t.shape[-1] // N_HEADS_A))


def _flip(t):
    return jnp.flip(t, axis=1)


def _layer_norm(x, g, b):
    xf = x.astype(jnp.float32)
    mu = jnp.mean(xf, axis=-1, keepdims=True)
    var = jnp.mean(jnp.square(xf - mu), axis=-1, keepdims=True)
    y = (xf - mu) * lax.rsqrt(var + LN_EPS) * g.astype(jnp.float32) + b.astype(jnp.float32)
    return y.astype(x.dtype)


def _hgrn2_forget(f_raw, lb):
    z = _heads(f_raw).astype(jnp.float32)
    lb = lb.reshape(N_HEADS_A, DK_A)
    log_f = jnp.logaddexp(jnp.log(lb), jnp.log1p(-lb) + jax.nn.log_sigmoid(z))
    k = (1.0 - lb) * jax.nn.sigmoid(-z)
    return log_f, k


def _gla_chunkwise(q, k, log_f, v, s0):
    bsz, length, h, _ = q.shape
    dv = v.shape[-1]
    n = length // CHUNK

    def to_chunks(t):
        return t.reshape(bsz, n, CHUNK, h, t.shape[-1]).transpose(1, 0, 3, 2, 4)

    mask = jnp.tril(jnp.ones((CHUNK, CHUNK), dtype=bool))[:, :, None]

    def step(s, inp):
        qi, ki, gi, vi = inp
        b = jnp.cumsum(gi, axis=2)
        diff = b[:, :, :, None, :] - b[:, :, None, :, :]
        decay = jnp.exp(jnp.where(mask, diff, -jnp.inf))
        att = jnp.einsum('bhtsd,bhsd->bhts', decay * qi[:, :, :, None, :], ki)
        o = (jnp.einsum('bhts,bhsv->bhtv', att, vi)
             + jnp.einsum('bhtd,bhdv->bhtv', qi * jnp.exp(b), s))
        b_last = b[:, :, -1:, :]
        s_new = (jnp.exp(b_last[:, :, 0, :])[..., None] * s
                 + jnp.einsum('bhsd,bhsv->bhdv', ki * jnp.exp(b_last - b), vi))
        return s_new, o

    s_fin, o = lax.scan(step, s0, (to_chunks(q), to_chunks(k), to_chunks(log_f), to_chunks(v)))
    o = o.transpose(1, 0, 3, 2, 4).reshape(bsz, length, h, dv)
    return o, s_fin


def _gla_final_state(k, log_f, v):
    b = jnp.cumsum(log_f, axis=1)
    w = jnp.exp(b[:, -1:] - b) * k
    return jnp.einsum('blhd,blhv->bhdv', w, v)


def _hgrn2_mix(pa, s_f0, s_b0, lb_f, lb_b, gn_g):
    f_fwd, f_bwd, i_v, q_raw, g_raw = jnp.split(pa, 5, axis=-1)
    v = _heads(i_v).astype(jnp.float32)
    q = jax.nn.silu(_heads(q_raw).astype(jnp.float32))
    log_ff, k_f = _hgrn2_forget(f_fwd, lb_f)
    log_fb, k_b = _hgrn2_forget(f_bwd, lb_b)
    o_f, s_f = _gla_chunkwise(q, k_f, log_ff, v, s_f0)
    o_b, s_b = _gla_chunkwise(_flip(q), _flip(k_b), _flip(log_fb), _flip(v), s_b0)
    o = o_f + _flip(o_b)
    o = (o * lax.rsqrt(jnp.mean(jnp.square(o), axis=-1, keepdims=True) + RMS_EPS)
         * gn_g.astype(jnp.float32) * jax.nn.silu(_heads(g_raw).astype(jnp.float32)))
    return o.reshape(o.shape[:2] + (WIDTH_A,)).astype(pa.dtype), s_f, s_b


def _hgrn2_ctx_states(pc, lb_f, lb_b):
    f_fwd, f_bwd, i_v = jnp.split(pc, 3, axis=-1)
    v = _heads(i_v).astype(jnp.float32)
    log_ff, k_f = _hgrn2_forget(f_fwd, lb_f)
    log_fb, k_b = _hgrn2_forget(f_bwd, lb_b)
    s_f = _gla_final_state(k_f, log_ff, v)
    s_b = _gla_final_state(_flip(k_b), _flip(log_fb), _flip(v))
    return s_f, s_b


def _conv_centred(z, w, axis):
    n = z.shape[axis]
    half = CONV_W // 2
    pad = [(0, 0)] * z.ndim
    pad[axis] = (half, half)
    zp = jnp.pad(z, pad)
    out = lax.slice_in_dim(zp, 0, n, axis=axis) * w[0]
    for j in range(1, CONV_W):
        out = out + lax.slice_in_dim(zp, j, j + n, axis=axis) * w[j]
    return out


def _short_conv(pb, conv_w, rows):
    b_gate, c_gate, h = jnp.split(pb, 3, axis=-1)
    z = c_gate * h
    if rows is None:
        y = _conv_centred(z, conv_w, axis=1)
    else:
        bsz, seq, width = z.shape
        y = _conv_centred(z.reshape(bsz, rows, GRID_W, width), conv_w, axis=2).reshape(bsz, seq, width)
    return b_gate * y


def _merge(o_a, z_b, pg, w_out_a, w_out_b, w_o):
    g_a, g_b = jnp.split(pg, 2, axis=-1)
    y = jax.nn.sigmoid(g_a) * (o_a @ w_out_a) + jax.nn.sigmoid(g_b) * (z_b @ w_out_b)
    return y @ w_o


def _token_mixer(u, uc, rows, w_in, conv_w, gn_g, w_out_a, w_out_b, w_o, lb_f, lb_b, with_ctx_out):
    bsz = u.shape[0]
    if with_ctx_out:
        zero = jnp.zeros((bsz, N_HEADS_A, DK_A, DV_A), jnp.float32)
        pc = uc @ w_in
        oc, s_f, s_b = _hgrn2_mix(pc[..., :A_COLS], zero, zero, lb_f, lb_b, gn_g)
        zc = _short_conv(pc[..., A_COLS:A_COLS + B_COLS], conv_w, None)
        yc = _merge(oc, zc, pc[..., A_COLS + B_COLS:], w_out_a, w_out_b, w_o)
    else:
        s_f, s_b = _hgrn2_ctx_states(uc @ w_in[:, :A_STATE_COLS], lb_f, lb_b)
        yc = None
    p = u @ w_in
    o, _, _ = _hgrn2_mix(p[..., :A_COLS], s_f, s_b, lb_f, lb_b, gn_g)
    z = _short_conv(p[..., A_COLS:A_COLS + B_COLS], conv_w, rows)
    y = _merge(o, z, p[..., A_COLS + B_COLS:], w_out_a, w_out_b, w_o)
    return y, yc


def _sq_relu_mlp(u, w_up, w_down):
    return jnp.square(jax.nn.relu(u @ w_up)) @ w_down


def setup_inputs(seed: int = 0) -> dict:
    key = jax.random.key(seed)
    ks = jax.random.split(key, 17)
    nrm = jax.random.normal
    f32 = jnp.float32
    return {
        "x": nrm(ks[0], (BATCH, SEQ, D_MODEL), f32),
        "c": nrm(ks[1], (BATCH, D_MODEL), f32),
        "ctx": nrm(ks[2], (BATCH, CTX_LEN, D_MODEL), f32),
        "c_ctx": nrm(ks[3], (D_MODEL,), f32),
        "w_ada": nrm(ks[4], (DEPTH, D_MODEL, N_MOD), f32) * (0.5 * D_MODEL ** -0.5),
        "b_ada": nrm(ks[5], (DEPTH, N_MOD), f32) * 0.02,
        "w_in": nrm(ks[6], (DEPTH, D_MODEL, N_IN), f32) * D_MODEL ** -0.5,
        "conv_w": nrm(ks[7], (DEPTH, CONV_W, WIDTH_B), f32) * CONV_W ** -0.5,
        "gnorm_g": 1.0 + 0.02 * nrm(ks[8], (DEPTH, DV_A), f32),
        "w_out_a": nrm(ks[9], (DEPTH, WIDTH_A, D_MODEL), f32) * (BETA * WIDTH_A ** -0.5),
        "w_out_b": nrm(ks[10], (DEPTH, WIDTH_B, D_MODEL), f32) * (BETA * WIDTH_B ** -0.5),
        "w_o": nrm(ks[11], (DEPTH, D_MODEL, D_MODEL), f32) * (BETA * D_MODEL ** -0.5),
        "w_up": nrm(ks[12], (DEPTH, D_MODEL, D_FF), f32) * D_MODEL ** -0.5,
        "w_down": nrm(ks[13], (DEPTH, D_FF, D_MODEL), f32) * (BETA * D_FF ** -0.5),
        "ln_g": 1.0 + 0.02 * nrm(ks[14], (DEPTH, 2, D_MODEL), f32),
        "ln_b": 0.02 * nrm(ks[15], (DEPTH, 2, D_MODEL), f32),
        "lower_bounds": 0.1 * nrm(ks[16], (DEPTH, 2, WIDTH_A), f32),
    }


def reference(x, c, ctx, c_ctx, w_ada, b_ada, w_in, conv_w, gnorm_g, w_out_a, w_out_b, w_o,
              w_up, w_down, ln_g, ln_b, lower_bounds):
    rows = x.shape[1] // GRID_W
    lb = jax.nn.softmax(lower_bounds.astype(jnp.float32), axis=0)
    lb = jnp.cumsum(lb, axis=0) - lb[0]
    silu_c = jax.nn.silu(c)
    silu_cc = jax.nn.silu(c_ctx)
    xc = ctx
    for l in range(DEPTH):
        last = l == DEPTH - 1
        mod = (silu_c @ w_ada[l] + b_ada[l])[:, None, :]
        mod_c = silu_cc @ w_ada[l] + b_ada[l]
        sh1, sc1, g1, sh2, sc2, g2 = jnp.split(mod, 6, axis=-1)
        csh1, csc1, cg1, csh2, csc2, cg2 = jnp.split(mod_c, 6, axis=-1)
        u = x * (1.0 + sc1) + sh1
        uc = xc * (1.0 + csc1) + csh1
        y, yc = _token_mixer(u, uc, rows, w_in[l], conv_w[l], gnorm_g[l], w_out_a[l], w_out_b[l],
                             w_o[l], lb[l, 0], lb[l, 1], not last)
        x = _layer_norm(ALPHA * x + g1 * y, ln_g[l, 0], ln_b[l, 0])
        x = _layer_norm(ALPHA * x + g2 * _sq_relu_mlp(x * (1.0 + sc2) + sh2, w_up[l], w_down[l]),
                        ln_g[l, 1], ln_b[l, 1])
        if not last:
            xc = _layer_norm(ALPHA * xc + cg1 * yc, ln_g[l, 0], ln_b[l, 0])
            xc = _layer_norm(ALPHA * xc + cg2 * _sq_relu_mlp(xc * (1.0 + csc2) + csh2, w_up[l], w_down[l]),
                             ln_g[l, 1], ln_b[l, 1])
    return x
```

```cpp
#include <hip/hip_runtime.h>
#include <cstdio>
#include <cstdint>

#ifndef MK_SPLIT
#define MK_SPLIT 0
#endif

namespace pg8 {
#define PG8_LAS __attribute__((address_space(3)))
typedef unsigned short bf16_t;
typedef short bf16x8 __attribute__((ext_vector_type(8)));
typedef float f32x4 __attribute__((ext_vector_type(4)));
typedef unsigned u32x4 __attribute__((ext_vector_type(4)));
constexpr int BM = 256, BK = 64, HALF = 128, HTB = HALF * BK * 2  , STAGE_BYTES = 8 * HTB, NXCD = 8, WGM = 8;

__host__ __device__ __forceinline__ int lds_byte(int r, int c) { const int st = (r >> 4) * 2 + (c >> 5), rr = r & 15, cc = c & 31, ob = rr * 64 + cc * 2; return st * 1024 + (ob ^ (((ob >> 9) & 1) << 5)); }
__host__ __device__ __forceinline__ void stage_rc(int b, int& R, int& C) { const int st = b / 1024, sb = b % 1024, swz = sb ^ (((sb >> 9) & 1) << 5); R = (st >> 1) * 16 + swz / 64; C = (st & 1) * 32 + (swz % 64) / 2; }
__host__ __device__ __forceinline__ int perm32(int rho) { const int n = rho >> 4, i = rho & 15; return 8 * (i >> 2) + 4 * n + (i & 3); }

struct Unit { int pm, pn, kc, am, bn; };
struct Gemm { const bf16_t* A; const bf16_t* Bt; int M, N, K, Kc; };

struct StaticOrder {
    int nM, nN, nwg, G, c, amask = -1, bmask = -1, kc0 = 0;
    __host__ __device__ void init(int M, int N, int G_, int c_) { nM = M / BM; nN = N / BM; nwg = nM * nN; G = G_; c = c_; }
    __host__ __device__ bool next(int i, Unit& u) const {
        const long L = (long)i * G + c; if (L >= nwg) return false;
        int wgid = (int)L; { const int q = nwg / NXCD, r = nwg % NXCD, xcd = wgid % NXCD, off = wgid / NXCD; wgid = (xcd < r ? xcd * (q + 1) : r * (q + 1) + (xcd - r) * q) + off; }
        const int nig = WGM * nN, gid = wgid / nig, fm = gid * WGM, gsz = (nM - fm) < WGM ? (nM - fm) : WGM;
        u.pm = fm + ((wgid % nig) % gsz); u.pn = (wgid % nig) / gsz; u.kc = kc0; u.am = u.pm & amask; u.bn = u.pn & bmask; return true;
    }
    __device__ __forceinline__ void a_ready(const Unit&) const {}
    __device__ __forceinline__ void done(const Unit&) const {}
};

__device__ __forceinline__ unsigned cvt_pk_bf16(float lo, float hi) { unsigned r; asm volatile("v_cvt_pk_bf16_f32 %0, %1, %2" : "=v"(r) : "v"(lo), "v"(hi)); return r; }
__device__ __forceinline__ float bf_lo(unsigned w) { return __uint_as_float(w << 16); }
__device__ __forceinline__ float bf_hi(unsigned w) { return __uint_as_float(w & 0xffff0000u); }

struct SplitOrder {
    int G, c;
    __host__ __device__ void init(int G_, int c_) { G = G_; c = c_; }
    __host__ __device__ bool next(int i, Unit& u) const { const int L = i * G + c; if (L >= 256) return false; u.kc = L & 7; const int t = L >> 3; u.pm = t & 1; u.pn = t >> 1; u.am = u.pm; u.bn = u.pn; return true; }
    __device__ __forceinline__ void a_ready(const Unit&) const {}
    __device__ __forceinline__ void done(const Unit&) const {}
};

template <int ACT  > struct EpiStoreBf16 {
    static constexpr bool PERM = true, AFTER_DRAIN = false, HAS_MID = false;
    bf16_t* O; int ldc; int skip;
    __device__ __forceinline__ void mid(f32x4 (&)[2][2][4][2], const Unit&, int, int, int, int) const {}
    __device__ __forceinline__ void operator()(f32x4 (&acc)[2][2][4][2], const Unit& u, int wr, int wc, int fr, int fq) const {
        if (skip) return;
        const int row0 = u.pm * BM + wr * 64 + fr, col0 = u.pn * BM + wc * 32 + 8 * fq;
#pragma unroll
        for (int ai = 0; ai < 2; ++ai)
#pragma unroll
            for (int m = 0; m < 4; ++m) { bf16_t* rowp = O + (size_t)(row0 + ai * HALF + m * 16) * ldc + col0;
#pragma unroll
                for (int bj = 0; bj < 2; ++bj) { f32x4 v0 = acc[ai][bj][m][0], v1 = acc[ai][bj][m][1];
                    if (ACT == 1) {
#pragma unroll
                        for (int j = 0; j < 4; ++j) { const float a = fmaxf(v0[j], 0.f), b = fmaxf(v1[j], 0.f); v0[j] = a * a; v1[j] = b * b; } }
                    u32x4 w; w.x = cvt_pk_bf16(v0[0], v0[1]); w.y = cvt_pk_bf16(v0[2], v0[3]); w.z = cvt_pk_bf16(v1[0], v1[1]); w.w = cvt_pk_bf16(v1[2], v1[3]);
                    __builtin_nontemporal_store(w, (u32x4*)(rowp + bj * HALF));     } }
    }
};
struct EpiRes {
    static constexpr bool PERM = false, AFTER_DRAIN = false, HAS_MID = false;
    const float* xlat; const float* xctx; const float* modl; int which; float* R; float alpha;
    __device__ __forceinline__ void mid(f32x4 (&)[2][2][4][2], const Unit&, int, int, int, int) const {}
    __device__ __forceinline__ void operator()(f32x4 (&acc)[2][2][4][2], const Unit& u, int wr, int wc, int fr, int fq) const {
        const int rl0 = wr * 64 + fr, col0 = u.pn * BM + wc * 32 + 4 * fq;
        const int vec = u.pm < 16 ? 0 : (u.pm < 32 ? 1 : 2);
        const float* g = modl + vec * 24576 + which + col0;
        const float* xb = (u.pm < 32 ? xlat + (size_t)u.pm * BM * 4096 : xctx + (size_t)(u.pm - 32) * BM * 4096) + col0;
        float* rb = R + (size_t)u.pm * BM * 4096 + col0;
        f32x4 gv[2][2];
#pragma unroll
        for (int bj = 0; bj < 2; ++bj)
#pragma unroll
            for (int n = 0; n < 2; ++n) gv[bj][n] = *(const f32x4*)(g + bj * HALF + n * 16);
#pragma unroll
        for (int ai = 0; ai < 2; ++ai)
#pragma unroll
            for (int m = 0; m < 4; ++m) { const size_t ro = (size_t)(rl0 + ai * HALF + m * 16) * 4096;
#pragma unroll
                for (int bj = 0; bj < 2; ++bj)
#pragma unroll
                    for (int n = 0; n < 2; ++n) { const f32x4 xs = *(const f32x4*)(xb + ro + bj * HALF + n * 16);
                        *(f32x4*)(rb + ro + bj * HALF + n * 16) = xs * alpha + gv[bj][n] * acc[ai][bj][m][n]; }
                asm volatile("" ::: "memory"); }
    }
};
struct EpiSlab {
    static constexpr bool PERM = false, AFTER_DRAIN = false, HAS_MID = false;
    float* slab; int skip;
    __device__ __forceinline__ void mid(f32x4 (&)[2][2][4][2], const Unit&, int, int, int, int) const {}
    __device__ __forceinline__ void operator()(f32x4 (&acc)[2][2][4][2], const Unit& u, int wr, int wc, int fr, int fq) const {
        if (skip) return;
        float* rb = slab + ((size_t)u.kc * 512 + (size_t)u.pm * BM + wr * 64 + fr) * 4096 + u.pn * BM + wc * 32 + 4 * fq;
#pragma unroll
        for (int ai = 0; ai < 2; ++ai)
#pragma unroll
            for (int m = 0; m < 4; ++m)
#pragma unroll
                for (int bj = 0; bj < 2; ++bj)
#pragma unroll
                    for (int n = 0; n < 2; ++n) *(f32x4*)(rb + (size_t)(ai * HALF + m * 16) * 4096 + bj * HALF + n * 16) = acc[ai][bj][m][n];
    }
};
struct EpiPartB {
    static constexpr bool PERM = true, AFTER_DRAIN = false, HAS_MID = false;
    const bf16_t* P; bf16_t* YP;
    __device__ __forceinline__ void mid(f32x4 (&)[2][2][4][2], const Unit&, int, int, int, int) const {}
    __device__ __forceinline__ void operator()(f32x4 (&acc)[2][2][4][2], const Unit& u, int wr, int wc, int fr, int fq) const {
        const int row0 = u.pm * BM + wr * 64 + fr, col0 = u.pn * BM + wc * 32 + 8 * fq;
#pragma unroll
        for (int ai = 0; ai < 2; ++ai)
#pragma unroll
            for (int m = 0; m < 4; ++m) { const size_t row = (size_t)(row0 + ai * HALF + m * 16);
#pragma unroll
                for (int bj = 0; bj < 2; ++bj) { const u32x4 gb = *(const u32x4*)(P + row * 24576 + 20480 + col0 + bj * HALF);
                    float o[8];
#pragma unroll
                    for (int w = 0; w < 4; ++w) {
                        const float s0 = __builtin_amdgcn_rcpf(1.f + __builtin_amdgcn_exp2f(-1.44269504f * bf_lo(gb[w]))), s1 = __builtin_amdgcn_rcpf(1.f + __builtin_amdgcn_exp2f(-1.44269504f * bf_hi(gb[w])));
                        o[2 * w] = acc[ai][bj][m][w >> 1][(w & 1) * 2] * s0; o[2 * w + 1] = acc[ai][bj][m][w >> 1][(w & 1) * 2 + 1] * s1; }
                    u32x4 wv; wv.x = cvt_pk_bf16(o[0], o[1]); wv.y = cvt_pk_bf16(o[2], o[3]); wv.z = cvt_pk_bf16(o[4], o[5]); wv.w = cvt_pk_bf16(o[6], o[7]);
                    *(u32x4*)(YP + row * 4096 + col0 + bj * HALF) = wv; }
                asm volatile("" ::: "memory"); }
    }
};
struct EpiMergeA {
    static constexpr bool PERM = true, AFTER_DRAIN = false, HAS_MID = false;
    const bf16_t* P; const bf16_t* YP; bf16_t* Y;
    __device__ __forceinline__ void mid(f32x4 (&)[2][2][4][2], const Unit&, int, int, int, int) const {}
    __device__ __forceinline__ void operator()(f32x4 (&acc)[2][2][4][2], const Unit& u, int wr, int wc, int fr, int fq) const {
        const int row0 = u.pm * BM + wr * 64 + fr, col0 = u.pn * BM + wc * 32 + 8 * fq;
#pragma unroll
        for (int ai = 0; ai < 2; ++ai)
#pragma unroll
            for (int m = 0; m < 4; ++m) { const size_t row = (size_t)(row0 + ai * HALF + m * 16);
#pragma unroll
                for (int bj = 0; bj < 2; ++bj) { const u32x4 ga = *(const u32x4*)(P + row * 24576 + 16384 + col0 + bj * HALF), yp = *(const u32x4*)(YP + row * 4096 + col0 + bj * HALF);
                    float o[8];
#pragma unroll
                    for (int w = 0; w < 4; ++w) {
                        const float s0 = __builtin_amdgcn_rcpf(1.f + __builtin_amdgcn_exp2f(-1.44269504f * bf_lo(ga[w]))), s1 = __builtin_amdgcn_rcpf(1.f + __builtin_amdgcn_exp2f(-1.44269504f * bf_hi(ga[w])));
                        o[2 * w] = acc[ai][bj][m][w >> 1][(w & 1) * 2] * s0 + bf_lo(yp[w]); o[2 * w + 1] = acc[ai][bj][m][w >> 1][(w & 1) * 2 + 1] * s1 + bf_hi(yp[w]); }
                    u32x4 wv; wv.x = cvt_pk_bf16(o[0], o[1]); wv.y = cvt_pk_bf16(o[2], o[3]); wv.z = cvt_pk_bf16(o[4], o[5]); wv.w = cvt_pk_bf16(o[6], o[7]);
                    *(u32x4*)(Y + row * 4096 + col0 + bj * HALF) = wv; }
                asm volatile("" ::: "memory"); }
    }
};

template <class Epi, class Sched, bool ALIGN_EPI = false, bool SP2 = false>
__device__ __forceinline__ void gemm_phase(PG8_LAS unsigned char* lds, const Gemm g, const Sched& S, const Epi& E, const int tid) {
    const int wid = __builtin_amdgcn_readfirstlane(tid >> 6), lane = tid & 63, wr = wid >> 2, wc = wid & 3, fr = lane & 15, fq = lane >> 4;
    const int K = g.K, nt = g.Kc / BK;
    unsigned voffA[2], voffB[2];
#pragma unroll
    for (int i = 0; i < 2; ++i) { int R, C; stage_rc(tid * 16 + i * 8192, R, C); const int Rb = Epi::PERM ? ((R & ~31) + perm32(R & 31)) : R;
        voffA[i] = (unsigned)(R * K + C) * 2u; voffB[i] = (unsigned)(Rb * BK + C) * 2u; }
    const size_t kstep = (size_t)(BK * 2);
    const size_t hstep = (size_t)HALF * K * 2;
    const size_t tstep = 2 * hstep;
    const size_t kstepB = (size_t)BM * BK * 2, hstepB = (size_t)HALF * BK * 2;
    const unsigned ldsw = (unsigned)wid * 1024u;
    const int aoff = lds_byte(wr * 64 + fr, fq * 8), boff = lds_byte(wc * 32 + fr, fq * 8);
#define PG8_SA(b, h) (((b) * 2 + (h)) * HTB)
#define PG8_SB(b, h) ((4 + (b) * 2 + (h)) * HTB)
#define PG8_STAGE(bufoff, gbase, voff) do { _Pragma("unroll") for (int _i = 0; _i < 2; ++_i) \
        __builtin_amdgcn_global_load_lds((const unsigned*)((const char*)(gbase) + (voff)[_i]), (PG8_LAS unsigned*)(lds + (bufoff) + ldsw + _i * 8192), 16, 0, 0); } while (0)
#define PG8_LDA(dst, b, h) do { _Pragma("unroll") for (int m = 0; m < 4; ++m) _Pragma("unroll") for (int k = 0; k < 2; ++k) dst[m][k] = *(const PG8_LAS bf16x8*)(lds + PG8_SA(b, h) + aoff + m * 2048 + k * 1024); } while (0)
#define PG8_LDB(dst, b, h) do { _Pragma("unroll") for (int n = 0; n < 2; ++n) _Pragma("unroll") for (int k = 0; k < 2; ++k) dst[n][k] = *(const PG8_LAS bf16x8*)(lds + PG8_SB(b, h) + boff + n * 2048 + k * 1024); } while (0)
#define PG8_MMA(ai, bj, At, Bt) do { __builtin_amdgcn_s_setprio(1); _Pragma("unroll") for (int m = 0; m < 4; ++m) _Pragma("unroll") for (int n = 0; n < 2; ++n) _Pragma("unroll") for (int k = 0; k < 2; ++k) \
        acc[ai][bj][m][n] = __builtin_amdgcn_mfma_f32_16x16x32_bf16(Bt[n][k], At[m][k], acc[ai][bj][m][n], 0, 0, 0); __builtin_amdgcn_s_setprio(0); } while (0)
#define PG8_WAIT_V(n) asm volatile("s_waitcnt vmcnt(" #n ")" ::: "memory")
#define PG8_WAIT_L(n) asm volatile("s_waitcnt lgkmcnt(" #n ")" ::: "memory")
#define PG8_BAR __builtin_amdgcn_s_barrier()
#define PG8_SCHED __builtin_amdgcn_sched_barrier(0)
    Unit cur, nxt; int ui = 0;
    if (!S.next(0, cur)) return;
    f32x4 acc[2][2][4][2];
#pragma unroll
    for (int a = 0; a < 2; ++a)
#pragma unroll
        for (int b = 0; b < 2; ++b)
#pragma unroll
            for (int m = 0; m < 4; ++m)
#pragma unroll
                for (int n = 0; n < 2; ++n) acc[a][b][m][n] = (f32x4){0.f, 0.f, 0.f, 0.f};
    bf16x8 At[4][2], B0[2][2], B1[2][2];
    const size_t cstep = (size_t)g.Kc * 2, cstepB = (size_t)(g.Kc / BK) * kstepB;
    const char* cA = (const char*)g.A + (size_t)cur.am * tstep + (size_t)cur.kc * cstep; const char* cB = (const char*)g.Bt + (size_t)cur.bn * tstep + (size_t)cur.kc * cstepB;
    S.a_ready(cur);
    if constexpr (SP2) {
        PG8_STAGE(PG8_SB(0, 0), cB, voffB); PG8_STAGE(PG8_SB(0, 1), cB + hstepB, voffB); PG8_STAGE(PG8_SA(0, 0), cA, voffA); PG8_STAGE(PG8_SA(0, 1), cA + hstep, voffA);
        if (wr == 1) PG8_BAR;
        PG8_WAIT_V(2); PG8_BAR;
        PG8_STAGE(PG8_SB(1, 0), cB + kstepB, voffB); PG8_STAGE(PG8_SA(1, 0), cA + kstep, voffA); PG8_STAGE(PG8_SB(1, 1), cB + hstepB + kstepB, voffB);
        PG8_WAIT_V(6); PG8_BAR;
    } else {
        PG8_STAGE(PG8_SB(0, 0), cB, voffB); PG8_STAGE(PG8_SA(0, 0), cA, voffA); PG8_STAGE(PG8_SB(0, 1), cB + hstepB, voffB); PG8_STAGE(PG8_SA(0, 1), cA + hstep, voffA);
        if (wr == 1) PG8_BAR;
        PG8_WAIT_V(4); PG8_BAR;
        PG8_STAGE(PG8_SB(1, 0), cB + kstepB, voffB); PG8_STAGE(PG8_SA(1, 0), cA + kstep, voffA); PG8_STAGE(PG8_SB(1, 1), cB + hstepB + kstepB, voffB);
        PG8_WAIT_V(6); PG8_BAR;
    }
    for (;;) {
        const bool has_next = S.next(ui + 1, nxt);
        const char* nA = has_next ? (const char*)g.A + (size_t)nxt.am * tstep + (size_t)nxt.kc * cstep : cA; const char* nB = has_next ? (const char*)g.Bt + (size_t)nxt.bn * tstep + (size_t)nxt.kc * cstepB : cB;
        for (int t = 0; t < nt; t += 2) {
            const bool last = (t == nt - 2);
            const char* a1 = cA + (size_t)(t + 1) * kstep;
            const char* a2 = last ? nA : cA + (size_t)(t + 2) * kstep; const char* b2 = last ? nB : cB + (size_t)(t + 2) * kstepB;
            const char* a3 = a2 + kstep; const char* b3 = b2 + kstepB;
            if (last && has_next) S.a_ready(nxt);
            if constexpr (Epi::HAS_MID) { if (t == (nt >> 1)) E.mid(acc, cur, wr, wc, fr, fq); }
            if constexpr (SP2) {
            PG8_LDB(B0, 0, 0); PG8_LDB(B1, 0, 1); PG8_SCHED; PG8_LDA(At, 0, 0); PG8_STAGE(PG8_SA(1, 1), a1 + hstep, voffA);
            PG8_WAIT_V(8); PG8_WAIT_L(0); PG8_BAR; PG8_MMA(0, 0, At, B0); PG8_MMA(0, 1, At, B1); PG8_BAR; PG8_SCHED;
            PG8_LDA(At, 0, 1); PG8_STAGE(PG8_SB(0, 0), b2, voffB); PG8_STAGE(PG8_SB(0, 1), b2 + hstepB, voffB); PG8_STAGE(PG8_SA(0, 0), a2, voffA);
            PG8_WAIT_V(8); PG8_WAIT_L(0); PG8_BAR; PG8_MMA(1, 0, At, B0); PG8_MMA(1, 1, At, B1); PG8_BAR; PG8_SCHED;
            PG8_LDB(B0, 1, 0); PG8_LDB(B1, 1, 1); PG8_SCHED; PG8_LDA(At, 1, 0); PG8_STAGE(PG8_SA(0, 1), a2 + hstep, voffA);
            PG8_WAIT_V(8); PG8_WAIT_L(0); PG8_BAR; PG8_MMA(0, 0, At, B0); PG8_MMA(0, 1, At, B1); PG8_BAR; PG8_SCHED;
            PG8_LDA(At, 1, 1); PG8_STAGE(PG8_SB(1, 0), b3, voffB); PG8_STAGE(PG8_SB(1, 1), b3 + hstepB, voffB); PG8_STAGE(PG8_SA(1, 0), a3, voffA);
            PG8_WAIT_V(8); PG8_WAIT_L(0); PG8_BAR; PG8_MMA(1, 0, At, B0); PG8_MMA(1, 1, At, B1); PG8_BAR; PG8_SCHED;
            } else {
            PG8_LDB(B0, 0, 0); PG8_SCHED; PG8_LDA(At, 0, 0); PG8_STAGE(PG8_SA(1, 1), a1 + hstep, voffA);
            PG8_WAIT_L(8); PG8_BAR; PG8_WAIT_L(0); PG8_MMA(0, 0, At, B0); PG8_BAR; PG8_SCHED;
            PG8_LDB(B1, 0, 1); PG8_STAGE(PG8_SB(0, 0), b2, voffB);
            PG8_BAR; PG8_WAIT_L(0); PG8_MMA(0, 1, At, B1); PG8_BAR;
            PG8_LDA(At, 0, 1); PG8_STAGE(PG8_SA(0, 0), a2, voffA);
            PG8_BAR; PG8_WAIT_L(0); PG8_MMA(1, 0, At, B0); PG8_BAR; PG8_SCHED;
            PG8_STAGE(PG8_SB(0, 1), b2 + hstepB, voffB);
            PG8_WAIT_V(6); PG8_BAR; PG8_MMA(1, 1, At, B1); PG8_BAR;
            PG8_LDB(B0, 1, 0); PG8_SCHED; PG8_LDA(At, 1, 0); PG8_STAGE(PG8_SA(0, 1), a2 + hstep, voffA);
            PG8_WAIT_L(8); PG8_BAR; PG8_WAIT_L(0); PG8_MMA(0, 0, At, B0); PG8_BAR; PG8_SCHED;
            PG8_LDB(B1, 1, 1); PG8_STAGE(PG8_SB(1, 0), b3, voffB);
            PG8_BAR; PG8_WAIT_L(0); PG8_MMA(0, 1, At, B1); PG8_BAR;
            PG8_LDA(At, 1, 1); PG8_STAGE(PG8_SA(1, 0), a3, voffA);
            PG8_BAR; PG8_WAIT_L(0); PG8_MMA(1, 0, At, B0); PG8_BAR; PG8_SCHED;
            PG8_STAGE(PG8_SB(1, 1), b3 + hstepB, voffB);
            PG8_WAIT_V(6); PG8_BAR; PG8_MMA(1, 1, At, B1); PG8_BAR;
            }
        }
        if constexpr (ALIGN_EPI) { if (wr == 0) PG8_BAR; }
        if constexpr (!Epi::AFTER_DRAIN) { E(acc, cur, wr, wc, fr, fq); S.done(cur); }
        if (!has_next) break;
#pragma unroll
        for (int a = 0; a < 2; ++a)
#pragma unroll
            for (int b = 0; b < 2; ++b)
#pragma unroll
                for (int m = 0; m < 4; ++m)
#pragma unroll
                    for (int n = 0; n < 2; ++n) acc[a][b][m][n] = (f32x4){0.f, 0.f, 0.f, 0.f};
        cur = nxt; cA = nA; cB = nB; ++ui;
        if constexpr (ALIGN_EPI) { if (wr == 1) PG8_BAR; }
    }
    PG8_WAIT_V(0);
    if constexpr (!ALIGN_EPI) { if (wr == 0) PG8_BAR; }
    PG8_BAR;
    if constexpr (Epi::AFTER_DRAIN) { E.fused(acc, cur, wr, wc, fr, fq, lds, wid, lane); S.done(cur); }
#undef PG8_SA
#undef PG8_SB
#undef PG8_STAGE
#undef PG8_LDA
#undef PG8_LDB
#undef PG8_MMA
#undef PG8_WAIT_V
#undef PG8_WAIT_L
#undef PG8_BAR
#undef PG8_SCHED
}
}

constexpr int NWAVES = 8;
constexpr int D = 4096, NBATCH = 2, SEQ = 4096, CTXL = 256, ML = NBATCH * SEQ  , MC = NBATCH * CTXL  , MR = ML + MC  ;
constexpr int NIN = 24576, DFF = 16384, WA = 2048, NHEAD = 16, DK = 128, NMOD = 6 * D, NKB = MR / 16  ;
constexpr int C_FF = 0, C_FB = 2048, C_I = 4096, C_Q = 6144, C_G = 8192, C_BG = 10240, C_CG = 12288, C_H = 14336, C_GA = 16384, C_GB = 20480;
constexpr float LN_EPS = 1e-5f, RMS_EPS = 1e-6f;
constexpr float ALPHA = 1.41421356237309515f;
constexpr int KSPLIT = 32;

constexpr size_t MiB = 1u << 20;
constexpr size_t WS_CTL = 0, CTL_ZERO_BYTES = 1 * MiB;
constexpr size_t WS_MOD = 1 * MiB;
constexpr size_t WS_PART = 2 * MiB;
constexpr size_t WS_WIN = 20 * MiB, SZ_WIN = 192 * MiB;
constexpr size_t WS_WAB = 404 * MiB, SZ_WAB = 32 * MiB;
constexpr size_t WS_WO = 468 * MiB, SZ_WO = 32 * MiB;
constexpr size_t WS_WUP = 532 * MiB, SZ_WUP = 128 * MiB;
constexpr size_t WS_WDN = 788 * MiB, SZ_WDN = 128 * MiB;
constexpr size_t WS_U = 1044 * MiB;
constexpr size_t WS_P = 1112 * MiB;
constexpr size_t WS_QT = 1520 * MiB;
constexpr size_t WS_KBT = 1588 * MiB;
constexpr size_t WS_VT = 1656 * MiB;
constexpr size_t WS_ATT = 1690 * MiB;
constexpr size_t WS_EXPB = 1707 * MiB;
constexpr size_t WS_OF = 1716 * MiB;
constexpr size_t WS_OB = 1784 * MiB;
constexpr size_t WS_OAZB = 1852 * MiB;
constexpr size_t WS_YPRE = 1920 * MiB;
constexpr size_t WS_R = 1988 * MiB;
constexpr size_t WS_X1 = 2124 * MiB;
constexpr size_t WS_X2 = 2260 * MiB;
constexpr size_t WS_H = 2396 * MiB;
constexpr size_t WS_YPART = 2668 * MiB;
constexpr size_t WS_END = 2736 * MiB;
constexpr size_t WS_SLAB = WS_QT;
static_assert(WS_PART + (size_t)2 * KSPLIT * 3 * NIN * 4 <= WS_WIN && WS_WIN + 2 * SZ_WIN <= WS_WAB && WS_WAB + 2 * SZ_WAB <= WS_WO && WS_WO + 2 * SZ_WO <= WS_WUP && WS_WUP + 2 * SZ_WUP <= WS_WDN && WS_WDN + 2 * SZ_WDN <= WS_U, "ws map (weights)");
static_assert(WS_U + (size_t)MR * D * 2 <= WS_P && WS_P + (size_t)MR * NIN * 2 <= WS_QT && WS_QT + (size_t)NKB * 16 * 2 * 4096 <= WS_KBT && WS_KBT + (size_t)NKB * 16 * 2 * 4096 <= WS_VT && WS_VT + (size_t)NKB * 16 * 4096 <= WS_ATT, "ws map (act 1)");
static_assert(WS_ATT + (size_t)NKB * 16 * 2 * 1024 <= WS_EXPB && WS_EXPB + (size_t)NKB * 16 * 2 * 512 <= WS_OF && WS_OF + (size_t)MR * WA * 4 <= WS_OB && WS_OB + (size_t)MR * WA * 4 <= WS_OAZB && WS_OAZB + (size_t)MR * D * 2 <= WS_YPRE, "ws map (act 2)");
static_assert(WS_YPRE + (size_t)MR * D * 2 <= WS_R && WS_R + (size_t)MR * D * 4 <= WS_X1 && WS_X1 + (size_t)MR * D * 4 <= WS_X2 && WS_X2 + (size_t)MR * D * 4 <= WS_H && WS_H + (size_t)MR * DFF * 2 <= WS_END, "ws map (act 3)");
constexpr int CW_BAR = 4096;

constexpr int RING_OFF = 0, RING_BYTES = 131072;
constexpr int LDSCTL_OFF = RING_BYTES, MISC_OFF = LDSCTL_OFF + 320;
constexpr int LDS_BYTES = 147456;

#define GAS __attribute__((address_space(1)))
#define CAS __attribute__((address_space(4)))
#define LAS __attribute__((address_space(3)))
#define DI __device__ __forceinline__
typedef unsigned short bf16;
typedef unsigned v4u __attribute__((ext_vector_type(4)));
typedef unsigned v2u __attribute__((ext_vector_type(2)));
typedef float f32x4 __attribute__((ext_vector_type(4)));
typedef float f32x2 __attribute__((ext_vector_type(2)));
typedef float f32x16 __attribute__((ext_vector_type(16)));
typedef short bf16x8 __attribute__((ext_vector_type(8)));
typedef GAS unsigned gu32;
#define RLX_AGENT __ATOMIC_RELAXED, __HIP_MEMORY_SCOPE_AGENT
#define LDS_WAIT() asm volatile("s_waitcnt lgkmcnt(0)" ::: "memory")
#define VM_WAIT() asm volatile("s_waitcnt vmcnt(0)" ::: "memory")
#define MFMA32(a, b, c) __builtin_amdgcn_mfma_f32_32x32x16_bf16((a), (b), (c), 0, 0, 0)
DI unsigned f2bf(float f) { unsigned u = __builtin_bit_cast(unsigned, f); return (u + 0x7fffu + ((u >> 16) & 1u)) >> 16; }
typedef __bf16 bf16x2_t __attribute__((ext_vector_type(2)));
DI unsigned pk2(float lo, float hi) { const f32x2 v = {lo, hi}; return __builtin_bit_cast(unsigned, __builtin_convertvector(v, bf16x2_t)); }
DI float bflo(unsigned w) { return __uint_as_float(w << 16); }
DI float bfhi(unsigned w) { return __uint_as_float(w & 0xffff0000u); }
constexpr float L2E = 1.44269504088896341f;
DI float ex2(float x) { return __builtin_amdgcn_exp2f(x); }
DI float sigmoidf_(float x) { return __builtin_amdgcn_rcpf(1.f + ex2(-L2E * x)); }
DI int sigma16(int p) { return 8 * ((p >> 2) & 1) + 4 * (p >> 3) + (p & 3); }

#define XB_TMO      128
#define XB_XCNT(j)  (256  + 64 * (j))
#define XB_XSUB(j)  (1280 + 64 * (j))
#define XB_XGEN(j)  (2304 + 64 * (j))
#define XB_TOP      3328
#define XB_TOPGEN   3392
#define XCD_BAR_WORDS 3456
#define XB_SPIN_CAP (1u << 18)

__device__ __forceinline__ unsigned xb_ld(unsigned* p)              { return __hip_atomic_load(p, __ATOMIC_RELAXED, __HIP_MEMORY_SCOPE_AGENT); }
__device__ __forceinline__ unsigned xb_add(unsigned* p, unsigned v) { return __hip_atomic_fetch_add(p, v, __ATOMIC_RELAXED, __HIP_MEMORY_SCOPE_AGENT); }
__device__ __forceinline__ unsigned xb_xcc_id() { return (unsigned)__builtin_amdgcn_s_getreg((3 << 11) | 20) & 0xFu; }
#define XB_SPIN(cond, bar) do { unsigned _sp = 0; while (cond) { __builtin_amdgcn_s_sleep(1); \
    if ((++_sp & 255u) == 0u) { if (xb_ld(&(bar)[XB_TMO])) break; if (_sp > XB_SPIN_CAP) { atomicAdd(&(bar)[XB_TMO], 1u); break; } } } } while (0)

struct XcdBarrier {
    unsigned* bar; unsigned x;
    volatile LAS unsigned* st;
};

__device__ __forceinline__ XcdBarrier xcd_barrier_post(unsigned* bar, volatile LAS unsigned* st) {
    XcdBarrier b; b.bar = bar; b.x = xb_xcc_id(); b.st = st;
    if (threadIdx.x == 0) (void)xb_add(&bar[XB_XCNT(b.x)], 1u);
    return b;
}
__device__ __forceinline__ void xcd_barrier_complete(unsigned* bar, unsigned x, unsigned& nloc, unsigned& nx) {
    const unsigned G = gridDim.x * gridDim.y * gridDim.z;
    unsigned sum, cnt, mine, sp = 0u;
    for (;;) {
        sum = 0u; cnt = 0u; mine = 0u;
#pragma unroll
        for (unsigned j = 0; j < 16; ++j) { const unsigned c = xb_ld(&bar[XB_XCNT(j)]); sum += c; cnt += (c > 0u) ? 1u : 0u; mine = (j == x) ? c : mine; }
        if (sum == G) break;
        __builtin_amdgcn_s_sleep(1);
        if ((++sp & 255u) == 0u) { if (xb_ld(&bar[XB_TMO])) break; if (sp > XB_SPIN_CAP) { atomicAdd(&bar[XB_TMO], 1u); break; } }
    }
    nloc = mine > 0u ? mine : 1u; nx = cnt > 0u ? cnt : 1u;
}

__device__ __forceinline__ void xcd_barrier(const XcdBarrier& b) {
    asm volatile("s_waitcnt vmcnt(0)" ::: "memory");
    __syncthreads();
    if (threadIdx.x == 0) {
        unsigned* bar = b.bar;
        unsigned bx = b.x; asm volatile("" : "+s"(bx));
        __builtin_amdgcn_s_waitcnt(0);
        unsigned nloc = b.st[0], nx = b.st[1];
        if (nloc == 0u) { xcd_barrier_complete(bar, bx, nloc, nx); b.st[0] = nloc; b.st[1] = nx; }
        const unsigned old = xb_add(&bar[XB_XSUB(bx)], 1u);
        const unsigned gen = old / nloc;
        if (old + 1u == (gen + 1u) * nloc) {
            __builtin_amdgcn_fence(__ATOMIC_RELEASE, "agent");
            asm volatile("s_waitcnt vmcnt(0)" ::: "memory");
            const unsigned og = xb_add(&bar[XB_TOP], 1u);
            const unsigned tg = og / nx;
            if (og + 1u == (tg + 1u) * nx) xb_add(&bar[XB_TOPGEN], 1u);
            else XB_SPIN(xb_ld(&bar[XB_TOPGEN]) == tg, bar);
            __builtin_amdgcn_fence(__ATOMIC_ACQUIRE, "agent");
            xb_add(&bar[XB_XGEN(bx)], 1u);
            asm volatile("s_waitcnt vmcnt(0)" ::: "memory");
        } else {
            XB_SPIN(xb_ld(&bar[XB_XGEN(bx)]) == gen, bar);
            __builtin_amdgcn_fence(__ATOMIC_ACQUIRE, "agent");
            asm volatile("s_waitcnt vmcnt(0)" ::: "memory");
        }
    }
    __syncthreads();
}

struct Frame {
    LAS unsigned char* lds;
    volatile LAS unsigned* MISC;
    gu32* ctl;
    int tid, lane, wave;
    int G;
    unsigned char* ws;
};
DI float wave_sum(float v) {
#pragma unroll
    for (int o = 1; o < 64; o <<= 1) v += __shfl_xor(v, o);
    return v;
}
DI int row_vec(int row) { return row < SEQ ? 0 : (row < ML ? 1 : 2); }

struct P0Item { const float* src; bf16* dst; int N; };
DI void p0_load(const P0Item& it, int lane, f32x4 (&v)[8]) {
#pragma unroll
    for (int i = 0; i < 8; ++i) v[i] = *(const GAS f32x4*)(it.src + (size_t)(8 * i + (lane >> 3)) * it.N + (lane & 7) * 4);
}
DI void p0_emit(const P0Item& it, const f32x4 (&v)[8], LAS float* scr, int lane) {
#pragma unroll
    for (int i = 0; i < 8; ++i) { LAS float* w = scr + (8 * i + (lane >> 3)) * 33 + (lane & 7) * 4; w[0] = v[i][0]; w[1] = v[i][1]; w[2] = v[i][2]; w[3] = v[i][3]; }
    LDS_WAIT(); asm volatile("" ::: "memory");
#pragma unroll
    for (int jj = 0; jj < 4; ++jj) { const int q = 64 * jj + lane, n = q >> 3, c = q & 7; const LAS float* s = scr + (8 * c) * 33 + n;
        v4u o; o.x = pk2(s[0 * 33], s[1 * 33]); o.y = pk2(s[2 * 33], s[3 * 33]); o.z = pk2(s[4 * 33], s[5 * 33]); o.w = pk2(s[6 * 33], s[7 * 33]);
        *(GAS v4u*)(it.dst + (size_t)q * 8) = o; }
    LDS_WAIT(); asm volatile("" ::: "memory");
}
struct P0Args { const float *c, *c_ctx, *w_ada, *w_in, *w_out_a, *w_out_b, *w_o, *w_up, *w_down; };
constexpr int I_IN = (D / 64) * (NIN / 32), I_OA = (WA / 64) * (D / 32), I_O = (D / 64) * (D / 32), I_UP = (D / 64) * (DFF / 32), I_DN = (DFF / 64) * (D / 32);
constexpr int I_LAYER = I_IN + 2 * I_OA + I_O + I_UP + I_DN;
constexpr int BG_N1 = 9600  , BG_N3 = 15680  , BG_N4 = 19200  , BG_N5 = 9600  ;
constexpr int BG_S0 = I_LAYER - (BG_N1 + BG_N3 + BG_N4 + BG_N5);
constexpr int BG_S1 = BG_S0 + BG_N1, BG_S2 = BG_S1, BG_S3 = BG_S2 + BG_N3, BG_S4 = BG_S3 + BG_N4, BG_S5 = BG_S4 + BG_N5;
static_assert(BG_S0 >= I_IN && BG_S5 == I_LAYER, "layer 1's w_in is converted in the prologue (the last slot runs inside layer 1's w_in phase); the slots end the layer");
DI void convert_items(Frame& F, const P0Args& A, int lo, int hi, int gw, int NGW, LAS float* scr) {
    auto decode = [&](int itn, P0Item& o) {
        const int l = itn / I_LAYER; int r = itn % I_LAYER;
        const float* W; bf16* WT; int N, Ktot, koff = 0;
        if (r < I_IN) { W = A.w_in + (size_t)l * D * NIN; WT = (bf16*)(F.ws + WS_WIN + l * SZ_WIN); N = NIN; Ktot = D; }
        else if ((r -= I_IN) < I_OA) { W = A.w_out_a + (size_t)l * WA * D; WT = (bf16*)(F.ws + WS_WAB + l * SZ_WAB); N = D; Ktot = D; }
        else if ((r -= I_OA) < I_OA) { W = A.w_out_b + (size_t)l * WA * D; WT = (bf16*)(F.ws + WS_WAB + l * SZ_WAB); N = D; Ktot = D; koff = WA; }
        else if ((r -= I_OA) < I_O) { W = A.w_o + (size_t)l * D * D; WT = (bf16*)(F.ws + WS_WO + l * SZ_WO); N = D; Ktot = D; }
        else if ((r -= I_O) < I_UP) { W = A.w_up + (size_t)l * D * DFF; WT = (bf16*)(F.ws + WS_WUP + l * SZ_WUP); N = DFF; Ktot = D; }
        else { r -= I_UP; W = A.w_down + (size_t)l * DFF * D; WT = (bf16*)(F.ws + WS_WDN + l * SZ_WDN); N = D; Ktot = DFF; }
        const int nblk = N / 32, kb = r / nblk, nb = r % nblk, k0 = 64 * kb, n0 = 32 * nb;
        o.src = W + (size_t)k0 * N + n0; o.N = N;
        o.dst = WT + (((size_t)(n0 >> 8) * (Ktot / 64) + ((koff + k0) >> 6)) * 256 + (n0 & 255)) * 64;
    };
    int itn = lo + gw; P0Item ia, ib; f32x4 va[8], vb[8];
    if (itn < hi) { decode(itn, ia); p0_load(ia, F.lane, va); }
    while (itn < hi) {
        const int i2 = itn + NGW; if (i2 < hi) { decode(i2, ib); p0_load(ib, F.lane, vb); }
        p0_emit(ia, va, scr, F.lane);
        if (i2 >= hi) break;
        const int i3 = i2 + NGW; if (i3 < hi) { decode(i3, ia); p0_load(ia, F.lane, va); }
        p0_emit(ib, vb, scr, F.lane);
        itn = i3;
    }
}
DI void bg_convert(Frame& F, const P0Args& A, int wg0, int lo, int hi) {
    if ((int)blockIdx.x < wg0) return;
    const int gw = ((int)blockIdx.x - wg0) * NWAVES + F.wave, NGW = (F.G - wg0) * NWAVES;
    convert_items(F, A, I_LAYER + lo, I_LAYER + hi, gw, NGW, (LAS float*)(F.lds + RING_OFF + F.wave * 16384));
}
DI void phase0(Frame& F, const P0Args& A) {
    LAS float* sv = (LAS float*)(F.lds + RING_OFF);
    for (int i = F.tid; i < 3 * D; i += NWAVES * 64) { const int v = i / D, k = i % D; const float x = v < 2 ? A.c[v * D + k] : A.c_ctx[k]; sv[i] = x * sigmoidf_(x); }
    __syncthreads();
    const int gw = blockIdx.x * NWAVES + F.wave, NGW = F.G * NWAVES;
    float* part = (float*)(F.ws + WS_PART);
    constexpr int NCG = NIN / 256, NTASK = 2 * KSPLIT * NCG;
    for (int tk = gw; tk < NTASK; tk += NGW) {
        const int l = tk / (KSPLIT * NCG), rem = tk % (KSPLIT * NCG), kc = rem / NCG, cg = rem % NCG;
        const int n0 = cg * 256 + F.lane * 4, k0 = kc * (D / KSPLIT);
        const float* wp = A.w_ada + ((size_t)l * D + k0) * NIN + n0;
        f32x4 a0 = {0.f, 0.f, 0.f, 0.f}, a1 = a0, a2 = a0;
#pragma unroll 8
        for (int k = 0; k < D / KSPLIT; ++k) { const f32x4 w = *(const GAS f32x4*)(wp + (size_t)k * NIN);
            a0 += w * sv[k0 + k]; a1 += w * sv[D + k0 + k]; a2 += w * sv[2 * D + k0 + k]; }
        float* pp = part + ((size_t)(l * KSPLIT + kc) * 3) * NIN + n0;
        *(f32x4*)(pp) = a0; *(f32x4*)(pp + NIN) = a1; *(f32x4*)(pp + 2 * NIN) = a2;
    }
    __syncthreads();
    convert_items(F, A, 0, I_LAYER, gw, NGW, (LAS float*)(F.lds + RING_OFF + F.wave * 16384));
    convert_items(F, A, I_LAYER, I_LAYER + BG_S0, gw, NGW, (LAS float*)(F.lds + RING_OFF + F.wave * 16384));
}
DI void phase1(Frame& F, const float* b_ada) {
    const float* part = (const float*)(F.ws + WS_PART); float* mod = (float*)(F.ws + WS_MOD);
    for (int i = blockIdx.x * (NWAVES * 64) + F.tid; i < 2 * 3 * NIN; i += F.G * NWAVES * 64) {
        const int l = i / (3 * NIN), rem = i % (3 * NIN), v = rem / NIN, n = rem % NIN;
        float s = b_ada[l * NIN + n];
#pragma unroll 8
        for (int kc = 0; kc < KSPLIT; ++kc) s += part[((size_t)(l * KSPLIT + kc) * 3 + v) * NIN + n];
        mod[i] = s;
    }
}
DI void phase_modulate0(Frame& F, const float* x, const float* ctx) {
    const float* mod = (const float*)(F.ws + WS_MOD); bf16* U = (bf16*)(F.ws + WS_U);
    const int gw = blockIdx.x * NWAVES + F.wave, NGW = F.G * NWAVES;
    for (int row = gw; row < MR; row += NGW) {
        const float* xr = row < ML ? x + (size_t)row * D : ctx + (size_t)(row - ML) * D;
        const float* mv = mod + row_vec(row) * NIN;
        bf16* ur = U + (size_t)row * D;
#pragma unroll 4
        for (int j = 0; j < 16; ++j) { const int c = j * 256 + F.lane * 4;
            const f32x4 v = *(const GAS f32x4*)(xr + c), sh = *(const f32x4*)(mv + c), sc = *(const f32x4*)(mv + D + c);
            const f32x4 o = v * (sc + 1.f) + sh; v2u w; w.x = pk2(o[0], o[1]); w.y = pk2(o[2], o[3]); *(GAS v2u*)(ur + c) = w; }
    }
}
template <bool HAS_MOD, bool CTX_SPLIT>
DI void phase_ln(Frame& F, const float* R, const float* g, const float* b, float* xo, int nrows, const float* mv_base  , int sh_off, int sc_off,
                 const float* slab  , const float* xres_ctx  , const float* gate_ctx  ) {
    bf16* U = (bf16*)(F.ws + WS_U);
    LAS float* red1 = (LAS float*)(F.lds + RING_OFF); LAS float* red2 = red1 + 64;
    const int nlat = CTX_SPLIT ? ML / F.G : 0, nctx = CTX_SPLIT ? MC / F.G : 0;
    const int rpw = CTX_SPLIT ? nlat + nctx : (nrows + F.G - 1) / F.G, row0 = blockIdx.x * rpw;
#define LN_ROW(k) (CTX_SPLIT ? ((k) < nlat ? (int)blockIdx.x * nlat + (k) : ML + (int)blockIdx.x * nctx + ((k) - nlat)) : row0 + (k))
    const int c0 = F.wave * 512 + F.lane * 8;
    f32x4 gc0 = {0.f, 0.f, 0.f, 0.f}, gc1 = gc0;
    if (CTX_SPLIT) { gc0 = *(const f32x4*)(gate_ctx + c0); gc1 = *(const f32x4*)(gate_ctx + c0 + 4); }
    const f32x4 g0 = *(const f32x4*)(g + c0), g1 = *(const f32x4*)(g + c0 + 4), b0 = *(const f32x4*)(b + c0), b1 = *(const f32x4*)(b + c0 + 4);
    f32x4 sc0 = {0.f, 0.f, 0.f, 0.f}, sc1 = sc0, sh0 = sc0, sh1 = sc0; int cur_vec = -1;
    auto ln_load = [&](int rb, f32x4 (&v)[8][2]) {
#pragma unroll
        for (int i = 0; i < 8; ++i) { const int row = LN_ROW(rb + i); const bool ok = (rb + i < rpw) && row < nrows;
            if (ok && CTX_SPLIT && row >= ML) { const size_t ro = (size_t)(row - ML) * D + c0;
                f32x4 a0 = *(const GAS f32x4*)(slab + ro), a1 = *(const GAS f32x4*)(slab + ro + 4);
#pragma unroll
                for (int kc = 1; kc < 8; ++kc) { a0 += *(const GAS f32x4*)(slab + (size_t)kc * MC * D + ro); a1 += *(const GAS f32x4*)(slab + (size_t)kc * MC * D + ro + 4); }
                v[i][0] = *(const GAS f32x4*)(xres_ctx + ro) * ALPHA + gc0 * a0; v[i][1] = *(const GAS f32x4*)(xres_ctx + ro + 4) * ALPHA + gc1 * a1; }
            else if (ok) { const float* rr = R + (size_t)row * D + c0; v[i][0] = *(const GAS f32x4*)rr; v[i][1] = *(const GAS f32x4*)(rr + 4); }
            else { v[i][0] = (f32x4){0.f, 0.f, 0.f, 0.f}; v[i][1] = v[i][0]; } }
    };
    auto ln_process = [&](int rb, f32x4 (&v)[8][2]) {
        float s[8];
#pragma unroll
        for (int i = 0; i < 8; ++i) s[i] = ((v[i][0][0] + v[i][0][1]) + (v[i][0][2] + v[i][0][3])) + ((v[i][1][0] + v[i][1][1]) + (v[i][1][2] + v[i][1][3]));
#pragma unroll
        for (int o = 1; o < 64; o <<= 1) {
#pragma unroll
            for (int i = 0; i < 8; ++i) s[i] += __shfl_xor(s[i], o); }
        if (F.lane < 8) { float t = s[0];
#pragma unroll
            for (int i = 1; i < 8; ++i) t = F.lane == i ? s[i] : t;
            red1[F.lane * 8 + F.wave] = t; }
        __syncthreads();
        float mean[8];
#pragma unroll
        for (int i = 0; i < 8; ++i) { const f32x4 p0 = *(const LAS f32x4*)(red1 + i * 8), p1 = *(const LAS f32x4*)(red1 + i * 8 + 4);
            mean[i] = (((p0[0] + p0[1]) + (p0[2] + p0[3])) + ((p1[0] + p1[1]) + (p1[2] + p1[3]))) * (1.f / D); }
#pragma unroll
        for (int i = 0; i < 8; ++i) { v[i][0] = v[i][0] - mean[i]; v[i][1] = v[i][1] - mean[i];
            s[i] = ((v[i][0][0] * v[i][0][0] + v[i][0][1] * v[i][0][1]) + (v[i][0][2] * v[i][0][2] + v[i][0][3] * v[i][0][3])) + ((v[i][1][0] * v[i][1][0] + v[i][1][1] * v[i][1][1]) + (v[i][1][2] * v[i][1][2] + v[i][1][3] * v[i][1][3])); }
#pragma unroll
        for (int o = 1; o < 64; o <<= 1) {
#pragma unroll
            for (int i = 0; i < 8; ++i) s[i] += __shfl_xor(s[i], o); }
        if (F.lane < 8) { float t = s[0];
#pragma unroll
            for (int i = 1; i < 8; ++i) t = F.lane == i ? s[i] : t;
            red2[F.lane * 8 + F.wave] = t; }
        __syncthreads();
#pragma unroll
        for (int i = 0; i < 8; ++i) { const int row = LN_ROW(rb + i); const bool ok = (rb + i < rpw) && row < nrows;
            const f32x4 p0 = *(const LAS f32x4*)(red2 + i * 8), p1 = *(const LAS f32x4*)(red2 + i * 8 + 4);
            const float var = (((p0[0] + p0[1]) + (p0[2] + p0[3])) + ((p1[0] + p1[1]) + (p1[2] + p1[3]))) * (1.f / D);
            const float rstd = 1.f / sqrtf(var + LN_EPS);
            if (ok) {
                const f32x4 y0 = v[i][0] * rstd * g0 + b0, y1 = v[i][1] * rstd * g1 + b1;
                float* xr = xo + (size_t)row * D + c0; *(GAS f32x4*)xr = y0; *(GAS f32x4*)(xr + 4) = y1;
                if (HAS_MOD) { const int vec = row_vec(row);
                    if (vec != cur_vec) { const float* mv = mv_base + vec * NIN + c0; sc0 = *(const f32x4*)(mv + sc_off); sc1 = *(const f32x4*)(mv + sc_off + 4); sh0 = *(const f32x4*)(mv + sh_off); sh1 = *(const f32x4*)(mv + sh_off + 4); cur_vec = vec; }
                    const f32x4 o0 = y0 * (sc0 + 1.f) + sh0, o1 = y1 * (sc1 + 1.f) + sh1;
                    v4u w; w.x = pk2(o0[0], o0[1]); w.y = pk2(o0[2], o0[3]); w.z = pk2(o1[0], o1[1]); w.w = pk2(o1[2], o1[3]);
                    *(GAS v4u*)(U + (size_t)row * D + c0) = w; } } }
    };
    f32x4 va[8][2], vb[8][2];
    ln_load(0, va);
    for (int rb = 0; rb < rpw; rb += 16) {
        if (rb + 8 < rpw) ln_load(rb + 8, vb);
        ln_process(rb, va);
        if (rb + 8 >= rpw) break;
        if (rb + 16 < rpw) ln_load(rb + 16, va);
        ln_process(rb + 8, vb);
    }
    __syncthreads();
#undef LN_ROW
}
DI void prep_task(Frame& F, const bf16* P, const float* lbnd  , int layer, int kb, int head, LAS unsigned char* wl  , int nost  ) {
    const int lane = F.lane;
    const bf16* prow = P + (size_t)(16 * kb) * NIN + head * DK + 2 * lane;
    unsigned zf[16], zb[16], qq[16], vv[16];
#pragma unroll
    for (int t = 0; t < 16; ++t) { const bf16* pr = prow + (size_t)t * NIN;
        zf[t] = *(const GAS unsigned*)(pr + C_FF); zb[t] = *(const GAS unsigned*)(pr + C_FB); qq[t] = *(const GAS unsigned*)(pr + C_Q); vv[t] = *(const GAS unsigned*)(pr + C_I); }
    const size_t kh = (size_t)kb * 16 + head;
    {
        unsigned lo[8], hi[8];
#pragma unroll
        for (int m = 0; m < 8; ++m) { const int s0 = sigma16(2 * m); lo[m] = (vv[s0] & 0xffffu) | (vv[s0 + 1] << 16); hi[m] = (vv[s0] >> 16) | (vv[s0 + 1] & 0xffff0000u); }
        GAS v4u* o = (GAS v4u*)(F.ws + WS_VT + kh * 4096 + (size_t)(2 * lane) * 32);
        if (!nost) { o[0] = (v4u){lo[0], lo[1], lo[2], lo[3]}; o[1] = (v4u){lo[4], lo[5], lo[6], lo[7]}; o[2] = (v4u){hi[0], hi[1], hi[2], hi[3]}; o[3] = (v4u){hi[4], hi[5], hi[6], hi[7]}; }
    }
    float qs0[16], qs1[16];
#pragma unroll
    for (int t = 0; t < 16; ++t) { const float a = bflo(qq[t]), b = bfhi(qq[t]); qs0[t] = a * sigmoidf_(a); qs1[t] = b * sigmoidf_(b); }
    LAS unsigned char* lq = wl; LAS unsigned char* lk = wl + 16 * 272;
    const int d0 = 2 * lane, dpos = 16 * (d0 >> 4) + sigma16(d0 & 15);
    const int dl = d0 & 31, epos = (d0 >> 5) * 32 + ((dl >> 2) & 1) * 16 + ((dl & 3) | ((dl >> 3) << 2));
#pragma unroll
    for (int dir = 0; dir < 2; ++dir) {
        const size_t idx = kh * 2 + dir;
        float lb0 = 0.f, lb1 = 0.f;
        if (layer == 1) { const float* lp = lbnd + dir * WA + head * DK + d0;
            lb0 = __builtin_amdgcn_rcpf(1.f + ex2(L2E * (lp[0] - lp[2 * WA]))); lb1 = __builtin_amdgcn_rcpf(1.f + ex2(L2E * (lp[1] - lp[2 * WA + 1]))); }
        float b0[16], b1[16], k0[16], k1[16]; float c0 = 0.f, c1 = 0.f;
#pragma unroll
        for (int i = 0; i < 16; ++i) { const int t = dir ? 15 - i : i; const unsigned zw = dir ? zb[t] : zf[t];
            const float z0 = bflo(zw), z1 = bfhi(zw);
            const float e0 = ex2(-L2E * fabsf(z0)), e1 = ex2(-L2E * fabsf(z1)), r0 = __builtin_amdgcn_rcpf(1.f + e0), r1 = __builtin_amdgcn_rcpf(1.f + e1);
            const float sp0 = z0 >= 0.f ? r0 : e0 * r0, sm0 = z0 >= 0.f ? e0 * r0 : r0, sp1 = z1 >= 0.f ? r1 : e1 * r1, sm1 = z1 >= 0.f ? e1 * r1 : r1;
            c0 += __builtin_amdgcn_logf(fmaxf(lb0 + (1.f - lb0) * sp0, 1e-37f)); c1 += __builtin_amdgcn_logf(fmaxf(lb1 + (1.f - lb1) * sp1, 1e-37f));
            b0[t] = c0; b1[t] = c1; k0[t] = (1.f - lb0) * sm0; k1[t] = (1.f - lb1) * sm1; }
        float kb0[16], kb1[16];
#pragma unroll
        for (int t = 0; t < 16; ++t) {
            const float eb0 = ex2(b0[t]), eb1 = ex2(b1[t]);
            const unsigned qt = pk2(qs0[t] * eb0, qs1[t] * eb1);
            const unsigned kt = pk2(k0[t] * ex2(fminf(-b0[t], 115.f)), k1[t] * ex2(fminf(-b1[t], 115.f)));
            kb0[t] = k0[t] * ex2(c0 - b0[t]); kb1[t] = k1[t] * ex2(c1 - b1[t]);
            *(LAS unsigned*)(lq + t * 272 + 4 * lane) = qt; *(LAS unsigned*)(lk + t * 272 + 4 * lane) = kt;
            if (!nost) *(GAS unsigned*)(F.ws + WS_QT + idx * 4096 + (size_t)t * 256 + dpos * 2) = qt; }
        {
            unsigned w0[8], w1[8];
#pragma unroll
            for (int m = 0; m < 8; ++m) { const int s0 = sigma16(2 * m); w0[m] = pk2(kb0[s0], kb0[s0 + 1]); w1[m] = pk2(kb1[s0], kb1[s0 + 1]); }
            GAS v4u* o = (GAS v4u*)(F.ws + WS_KBT + idx * 4096 + (size_t)d0 * 32);
            if (!nost) { o[0] = (v4u){w0[0], w0[1], w0[2], w0[3]}; o[1] = (v4u){w0[4], w0[5], w0[6], w0[7]}; o[2] = (v4u){w1[0], w1[1], w1[2], w1[3]}; o[3] = (v4u){w1[4], w1[5], w1[6], w1[7]}; }
        }
        if (!nost) *(GAS f32x2*)(F.ws + WS_EXPB + idx * 512 + (size_t)epos * 4) = (f32x2){ex2(c0), ex2(c1)};
        LDS_WAIT(); asm volatile("" ::: "memory");
        const int r = lane & 31, hh = lane >> 5;
        f32x16 X;
#pragma unroll
        for (int i = 0; i < 16; ++i) X[i] = 0.f;
#pragma unroll
        for (int ks = 0; ks < 8; ++ks) { const int off = (r & 15) * 272 + (16 * ks + 8 * hh) * 2;
            const bf16x8 ak = *(const LAS bf16x8*)(lk + off), bq = *(const LAS bf16x8*)(lq + off); X = MFMA32(ak, bq, X); }
        unsigned aw[4];
#pragma unroll
        for (int w = 0; w < 4; ++w) { const int j0 = 2 * w, j1 = 2 * w + 1, s0 = (j0 & 3) + 8 * (j0 >> 2) + 4 * hh, s1 = (j1 & 3) + 8 * (j1 >> 2) + 4 * hh;
            const bool k0_ = r < 16 && (dir ? s0 >= r : s0 <= r), k1_ = r < 16 && (dir ? s1 >= r : s1 <= r);
            aw[w] = pk2(k0_ ? X[j0] : 0.f, k1_ ? X[j1] : 0.f); }
        if (!nost) *(GAS v4u*)(F.ws + WS_ATT + idx * 1024 + (size_t)lane * 16) = (v4u){aw[0], aw[1], aw[2], aw[3]};
        asm volatile("" ::: "memory");
    }
}
constexpr int SC_Q = 0, SC_K = 4096, SC_V = 8192, SC_A = 12288, SC_E = 13312, SC_SLOT = 13824, SC_NSLOT = 8, SC_PD = SC_NSLOT - 1  , SC_WGS = 64, SC_NSTEP = 16 + 256;
DI int scan_kb(int j, int b, int dir) { if (j < 16) return 512 + 16 * b + (dir ? 15 - j : j); const int jj = j - 16; return 256 * b + (dir ? 255 - jj : jj); }
DI void scan_issue(const unsigned char* ws, LAS unsigned char* slot, int kb, int head, int dir, int h  , int lane) {
    const size_t kh = (size_t)kb * 16 + head, idx = kh * 2 + dir;
    __builtin_amdgcn_global_load_lds((const unsigned*)(ws + WS_QT + idx * 4096 + (size_t)((lane & 15) * 256 + (4 * h + (lane >> 4)) * 16)), (LAS unsigned*)(slot + SC_Q + h * 1024), 16, 0, 0);
    const size_t ro = (size_t)((64 * (h & 1) + lane) * 32 + (h >> 1) * 16);
    __builtin_amdgcn_global_load_lds((const unsigned*)(ws + WS_KBT + idx * 4096 + ro), (LAS unsigned*)(slot + SC_K + h * 1024), 16, 0, 0);
    __builtin_amdgcn_global_load_lds((const unsigned*)(ws + WS_VT + kh * 4096 + ro), (LAS unsigned*)(slot + SC_V + h * 1024), 16, 0, 0);
    if (h == 1 || h == 2) __builtin_amdgcn_global_load_lds((const unsigned*)(ws + WS_EXPB + idx * 512 + (size_t)(h - 1) * 256 + (size_t)lane * 4), (LAS unsigned*)(slot + SC_E + (h - 1) * 256), 4, 0, 0);
    else __builtin_amdgcn_global_load_lds((const unsigned*)(ws + WS_ATT + idx * 1024 + (size_t)lane * 16), (LAS unsigned*)(slot + SC_A), 16, 0, 0);
}
DI bf16x8 pack_rows(const f32x16& x, int s) {
    v4u p; p.x = pk2(x[8 * s], x[8 * s + 1]); p.y = pk2(x[8 * s + 2], x[8 * s + 3]); p.z = pk2(x[8 * s + 4], x[8 * s + 5]); p.w = pk2(x[8 * s + 6], x[8 * s + 7]);
    return __builtin_bit_cast(bf16x8, p);
}
DI void scan_step(f32x16 (&S)[4], const LAS unsigned char* slot, int vg, float* orow  , int lane) {
    const int r = lane & 31, hh = lane >> 5;
    const LAS unsigned char* qp = slot + SC_Q + (hh * 16 + (r & 15)) * 16;
    const LAS unsigned char* kp = slot + SC_K + (hh * 128 + r) * 16;
    const LAS f32x4* ep = (const LAS f32x4*)(slot + SC_E + hh * 64);
    bf16x8 qf[8], kf[4]; f32x4 e[4][4];
#pragma unroll
    for (int ks = 0; ks < 8; ++ks) qf[ks] = *(const LAS bf16x8*)(qp + ks * 512);
    const bf16x8 af = *(const LAS bf16x8*)(slot + SC_A + lane * 16), vf = *(const LAS bf16x8*)(slot + SC_V + (hh * 128 + 32 * vg + r) * 16);
#pragma unroll
    for (int dt = 0; dt < 4; ++dt) { kf[dt] = *(const LAS bf16x8*)(kp + dt * 512);
#pragma unroll
        for (int g = 0; g < 4; ++g) e[dt][g] = ep[dt * 8 + g]; }
    asm volatile("" ::: "memory");
    f32x16 O;
#pragma unroll
    for (int i = 0; i < 16; ++i) O[i] = 0.f;
#pragma unroll
    for (int dt = 0; dt < 4; ++dt)
#pragma unroll
        for (int s2 = 0; s2 < 2; ++s2) O = MFMA32(qf[2 * dt + s2], pack_rows(S[dt], s2), O);
    O = MFMA32(af, vf, O);
#pragma unroll
    for (int dt = 0; dt < 4; ++dt) {
#pragma unroll
        for (int c = 0; c < 4; ++c) { S[dt][c] *= e[dt][0][c]; S[dt][4 + c] *= e[dt][1][c]; S[dt][8 + c] *= e[dt][2][c]; S[dt][12 + c] *= e[dt][3][c]; }
        S[dt] = MFMA32(kf[dt], vf, S[dt]);
    }
#pragma unroll
    for (int i = 0; i < 8; ++i) { const int t = (i & 3) + 8 * (i >> 2) + 4 * hh; *(GAS float*)(orow + (size_t)t * WA) = O[i]; }
}
#define SC_WAIT(n) asm volatile("s_waitcnt vmcnt(" #n ")" ::: "memory")
#define SC_WAITN(n) asm volatile("s_waitcnt vmcnt(%0)" :: "n"(n) : "memory")
#define SC_BAR() do { asm volatile("" ::: "memory"); __builtin_amdgcn_s_barrier(); asm volatile("" ::: "memory"); } while (0)
DI void scan_wg(Frame& F, int stream) {
    const int lane = F.lane, dir = stream & 1, head = (stream >> 1) & 15, b = stream >> 5;
    LAS unsigned char* ring = F.lds + RING_OFF;
    if (F.wave >= 4) {
        const int h = F.wave - 4;
#pragma unroll
        for (int i = 0; i < SC_PD; ++i) scan_issue(F.ws, ring + i * SC_SLOT, scan_kb(i, b, dir), head, dir, h, lane);
        SC_WAITN(4 * (SC_PD - 1)); SC_BAR();
        for (int j = 0; j < SC_NSTEP; ++j) {
            const int jn = j + SC_PD < SC_NSTEP ? j + SC_PD : SC_NSTEP - 1;
            scan_issue(F.ws, ring + ((j + SC_PD) & (SC_NSLOT - 1)) * SC_SLOT, scan_kb(jn, b, dir), head, dir, h, lane);
            SC_WAITN(4 * (SC_PD - 1)); SC_BAR();
        }
        SC_WAIT(0);
    } else {
        const int vg = F.wave, r = lane & 31;
        float* obase = (float*)(F.ws + (dir ? WS_OB : WS_OF)) + head * DK + 32 * vg + r;
        f32x16 S[4];
#pragma unroll
        for (int dt = 0; dt < 4; ++dt)
#pragma unroll
            for (int i = 0; i < 16; ++i) S[dt][i] = 0.f;
        SC_BAR();
        for (int j = 0; j < SC_NSTEP; ++j) {
            scan_step(S, ring + (j & (SC_NSLOT - 1)) * SC_SLOT, vg, obase + (size_t)(16 * scan_kb(j, b, dir)) * WA, lane);
            SC_BAR();
        }
    }
}
DI void conv_strip(Frame& F, const float* cw  , int task) {
    const bf16* P = (const bf16*)(F.ws + WS_P); bf16* OZ = (bf16*)(F.ws + WS_OAZB);
    const int strip = task >> 2, ch = (task & 3) * 512 + F.lane * 8, row0 = strip * 8;
    const bool hp = row0 < ML ? (row0 & 63) != 0 : ((row0 - ML) & (CTXL - 1)) != 0;
    const bool hn = row0 < ML ? ((row0 + 8) & 63) != 0 : ((row0 + 8 - ML) & (CTXL - 1)) != 0;
    const bf16* pr = P + (size_t)row0 * NIN + ch;
    v4u cg[10], hg[10], bg[8];
#pragma unroll
    for (int j = 0; j < 10; ++j) { const bool ok = j == 0 ? hp : (j == 9 ? hn : true);
        if (ok) { cg[j] = *(const GAS v4u*)(pr + (ptrdiff_t)(j - 1) * NIN + C_CG); hg[j] = *(const GAS v4u*)(pr + (ptrdiff_t)(j - 1) * NIN + C_H); }
        else { cg[j] = (v4u){0u, 0u, 0u, 0u}; hg[j] = cg[j]; } }
#pragma unroll
    for (int i = 0; i < 8; ++i) bg[i] = *(const GAS v4u*)(pr + (size_t)i * NIN + C_BG);
    float w0[8], w1[8], w2[8];
#pragma unroll
    for (int q = 0; q < 2; ++q) { const f32x4 a = *(const f32x4*)(cw + ch + 4 * q), b = *(const f32x4*)(cw + WA + ch + 4 * q), c = *(const f32x4*)(cw + 2 * WA + ch + 4 * q);
#pragma unroll
        for (int k = 0; k < 4; ++k) { w0[4 * q + k] = a[k]; w1[4 * q + k] = b[k]; w2[4 * q + k] = c[k]; } }
    float zm[8], z0[8], zp[8];
#pragma unroll
    for (int w = 0; w < 4; ++w) { zm[2 * w] = bflo(cg[0][w]) * bflo(hg[0][w]); zm[2 * w + 1] = bfhi(cg[0][w]) * bfhi(hg[0][w]); z0[2 * w] = bflo(cg[1][w]) * bflo(hg[1][w]); z0[2 * w + 1] = bfhi(cg[1][w]) * bfhi(hg[1][w]); }
#pragma unroll
    for (int i = 0; i < 8; ++i) {
#pragma unroll
        for (int w = 0; w < 4; ++w) { zp[2 * w] = bflo(cg[i + 2][w]) * bflo(hg[i + 2][w]); zp[2 * w + 1] = bfhi(cg[i + 2][w]) * bfhi(hg[i + 2][w]); }
        unsigned ow[4];
#pragma unroll
        for (int w = 0; w < 4; ++w) {
            const float yl = w0[2 * w] * zm[2 * w] + w1[2 * w] * z0[2 * w] + w2[2 * w] * zp[2 * w], yh = w0[2 * w + 1] * zm[2 * w + 1] + w1[2 * w + 1] * z0[2 * w + 1] + w2[2 * w + 1] * zp[2 * w + 1];
            ow[w] = pk2(bflo(bg[i][w]) * yl, bfhi(bg[i][w]) * yh); }
        *(GAS v4u*)(OZ + (size_t)(row0 + i) * D + WA + ch) = (v4u){ow[0], ow[1], ow[2], ow[3]};
#pragma unroll
        for (int k = 0; k < 8; ++k) { zm[k] = z0[k]; z0[k] = zp[k]; }
    }
}
DI void phase_prep(Frame& F, const float* lbnd, int layer, const float* cw, int flags) {
    const bf16* P = (const bf16*)(F.ws + WS_P);
    const int gw = blockIdx.x * NWAVES + F.wave, NGW = F.G * NWAVES;
    LAS unsigned char* wl = F.lds + RING_OFF + F.wave * 16384;
    for (int tk = gw; tk < NKB * NHEAD; tk += NGW) prep_task(F, P, lbnd, layer, tk >> 4, tk & 15, wl, flags & 1024);
    if (!(flags & 2048)) for (int tk = gw; tk < (MR / 8) * 4; tk += NGW) conv_strip(F, cw, tk);
}
template <class GemmFn>
DI void phase_scan_gemm(Frame& F, int flags, const GemmFn& zb_gemm) {
    const int nsc = F.G >= 2 * SC_WGS ? SC_WGS : 0;
    if (nsc) {
        if ((int)blockIdx.x < nsc) { if (!(flags & 1)) scan_wg(F, (int)blockIdx.x); }
        else if (!(flags & 2)) zb_gemm(F.G - nsc, (int)blockIdx.x - nsc);
    } else {
        if (!(flags & 1)) for (int st = blockIdx.x; st < 64; st += F.G) { scan_wg(F, st); __syncthreads(); }
        if (!(flags & 2)) zb_gemm(F.G, (int)blockIdx.x);
    }
}
DI void phase_combine(Frame& F, const float* gn  , int nrows) {
    const bf16* P = (const bf16*)(F.ws + WS_P); bf16* OZ = (bf16*)(F.ws + WS_OAZB);
    const float* OF = (const float*)(F.ws + WS_OF); const float* OB = (const float*)(F.ws + WS_OB);
    const int gw = blockIdx.x * NWAVES + F.wave, NGW = F.G * NWAVES;
    const int vl = (F.lane & 15) * 8;
    const f32x4 g0 = *(const f32x4*)(gn + vl), g1 = *(const f32x4*)(gn + vl + 4);
    for (int row = gw; row < nrows; row += NGW) {
#pragma unroll
        for (int it = 0; it < 4; ++it) { const int ch = (it * 4 + (F.lane >> 4)) * DK + vl;
            const size_t off = (size_t)row * WA + ch;
            f32x4 a = *(const GAS f32x4*)(OF + off) + *(const GAS f32x4*)(OB + off), b = *(const GAS f32x4*)(OF + off + 4) + *(const GAS f32x4*)(OB + off + 4);
            const v4u gw4 = *(const GAS v4u*)(P + (size_t)row * NIN + C_G + ch);
            float ss = (a[0] * a[0] + a[1] * a[1]) + (a[2] * a[2] + a[3] * a[3]) + (b[0] * b[0] + b[1] * b[1]) + (b[2] * b[2] + b[3] * b[3]);
            ss += __shfl_xor(ss, 1); ss += __shfl_xor(ss, 2); ss += __shfl_xor(ss, 4); ss += __shfl_xor(ss, 8);
            const float rinv = 1.f / sqrtf(ss * (1.f / DK) + RMS_EPS);
            float gl[8];
#pragma unroll
            for (int w = 0; w < 4; ++w) { const float x0 = bflo(gw4[w]), x1 = bfhi(gw4[w]); gl[2 * w] = x0 * sigmoidf_(x0); gl[2 * w + 1] = x1 * sigmoidf_(x1); }
            a = a * rinv * g0; b = b * rinv * g1;
            v4u o; o.x = pk2(a[0] * gl[0], a[1] * gl[1]); o.y = pk2(a[2] * gl[2], a[3] * gl[3]); o.z = pk2(b[0] * gl[4], b[1] * gl[5]); o.w = pk2(b[2] * gl[6], b[3] * gl[7]);
            *(GAS v4u*)(OZ + (size_t)row * D + ch) = o; }
    }
}
constexpr int N_PHASES = 3 + 2 * 10;
struct Args { const float* in[17]; float* out; unsigned char* ws; int ph_lo, ph_hi, flags, pad; };
__global__ void __launch_bounds__(NWAVES * 64, 2) mk_fwd(Args args) {
    extern __shared__ __attribute__((aligned(16))) unsigned char lds[];
    Frame F;
    F.lds = (LAS unsigned char*)lds;
    F.MISC = (volatile LAS unsigned*)(F.lds + MISC_OFF);
    F.tid = threadIdx.x; F.lane = F.tid & 63; F.wave = __builtin_amdgcn_readfirstlane(F.tid >> 6);
    F.G = gridDim.x; F.ws = args.ws;
    F.ctl = (gu32*)(args.ws + WS_CTL);
    for (int u = F.tid; u < (LDS_BYTES - LDSCTL_OFF) / 4; u += NWAVES * 64) ((LAS unsigned*)(F.lds + LDSCTL_OFF))[u] = 0u;
    __syncthreads();
#if MK_SPLIT
#define GRID_BAR() do { } while (0)
#else
    XcdBarrier bar = xcd_barrier_post((unsigned*)(F.ctl + CW_BAR), F.MISC + 8);
#define GRID_BAR() xcd_barrier(bar)
#endif
    unsigned char* ws = args.ws; const CAS Args* ap = nullptr;
#define MODP ((const float*)(ws + WS_MOD))
    const int lo = args.ph_lo, hi = args.ph_hi; (void)lo; (void)hi;
#ifndef PH_MASK
#define PH_MASK 0xffff
#endif
#define EN(kind) (((PH_MASK) >> (kind)) & 1)
#ifndef DUP_MASK
#define DUP_MASK 0
#endif
#define REPS(kind) (1 + (((DUP_MASK) >> (kind)) & 1))
#ifndef RT_RANGE
#define RT_RANGE 0
#define PROBE_LO 0
#define PROBE_HI 0
#define PROBE_FLAGS 0
#endif
#if MK_SPLIT || RT_RANGE
#define IN(k) (lo <= (k) && (k) < hi)
#else
#define IN(k) true
#endif
#define REFRESH() do { int t_ = threadIdx.x; asm volatile("" : "+v"(t_)); F.tid = t_; F.lane = t_ & 63; ap = (const CAS Args*)__builtin_amdgcn_kernarg_segment_ptr(); asm volatile("" : "+s"(ap)); ws = ap->ws; F.ws = ws; } while (0)
#define INP(k) (ap->in[k])
#define SEAM(k) do { if (IN(k) && IN((k) + 1)) GRID_BAR(); } while (0)

    for (int rep_ = 0; rep_ < REPS(0); ++rep_) if (EN(0) && IN(0)) { if (rep_) GRID_BAR(); REFRESH(); P0Args A{INP(1), INP(3), INP(4), INP(6), INP(9), INP(10), INP(11), INP(12), INP(13)}; phase0(F, A); } SEAM(0);
    for (int rep_ = 0; rep_ < REPS(1); ++rep_) if (EN(1) && IN(1)) { if (rep_) GRID_BAR(); REFRESH(); phase1(F, INP(5)); } SEAM(1);
#ifdef PROBE_EXTRA_BARRIERS
    for (int xb_ = 0; xb_ < PROBE_EXTRA_BARRIERS; ++xb_) GRID_BAR();
#endif
    for (int rep_ = 0; rep_ < REPS(2); ++rep_) if (EN(2) && IN(2)) { if (rep_) GRID_BAR(); REFRESH(); phase_modulate0(F, INP(0), INP(2)); } SEAM(2);

    for (int l = 0; l < 2; ++l) {
        const int pb = 3 + 10 * l;
        const bool last = (l == 1);
        const int Mrows = last ? ML : MR;
#define MODL (MODP + (size_t)l * 3 * NIN)
        for (int rep_ = 0; rep_ < REPS(3); ++rep_) if (EN(3) && IN(pb + 0)) { if (rep_) GRID_BAR(); REFRESH();
            pg8::Gemm g{(const pg8::bf16_t*)(ws + WS_U), (const pg8::bf16_t*)(ws + WS_WIN + l * SZ_WIN), MR, NIN, D, D}; pg8::StaticOrder S; S.init(MR, NIN, F.G, (int)blockIdx.x);
            pg8::EpiStoreBf16<0> E{(pg8::bf16_t*)(ws + WS_P), NIN, 0};
            pg8::gemm_phase<pg8::EpiStoreBf16<0>, pg8::StaticOrder, true, true>(F.lds + RING_OFF, g, S, E, F.tid);
            if (F.G == 256 && !(ap->flags & 32)) { P0Args A{INP(1), INP(3), INP(4), INP(6), INP(9), INP(10), INP(11), INP(12), INP(13)}; bg_convert(F, A, 192, l == 0 ? BG_S0 : BG_S4, l == 0 ? BG_S1 : BG_S5); }
        } SEAM(pb + 0);
        for (int rep_ = 0; rep_ < REPS(4); ++rep_) if (EN(4) && IN(pb + 1)) { if (rep_) GRID_BAR(); REFRESH(); phase_prep(F, INP(16), l, INP(7) + (size_t)l * 3 * WA, ap->flags); } SEAM(pb + 1);
        for (int rep_ = 0; rep_ < REPS(5); ++rep_) if (EN(5) && IN(pb + 2)) { if (rep_) GRID_BAR(); REFRESH();
            const int fl = ap->flags;
            auto zb_gemm = [&](int G2, int c2) {
                pg8::Gemm g{(const pg8::bf16_t*)(ws + WS_OAZB), (const pg8::bf16_t*)(ws + WS_WAB + l * SZ_WAB), Mrows, D, D, D / 2}; pg8::StaticOrder S; S.init(Mrows, D, G2, c2); S.kc0 = 1;
                pg8::EpiPartB E{(const pg8::bf16_t*)(ws + WS_P), (pg8::bf16_t*)(ws + WS_YPART)};
                pg8::gemm_phase<pg8::EpiPartB, pg8::StaticOrder, true, true>(F.lds + RING_OFF, g, S, E, F.tid); };
            phase_scan_gemm(F, fl, zb_gemm);
        } SEAM(pb + 2);
        for (int rep_ = 0; rep_ < REPS(6); ++rep_) if (EN(6) && IN(pb + 3)) { if (rep_) GRID_BAR(); REFRESH(); phase_combine(F, INP(8) + l * DK, Mrows); } SEAM(pb + 3);
        for (int rep_ = 0; rep_ < REPS(7); ++rep_) if (EN(7) && IN(pb + 4)) { if (rep_) GRID_BAR(); REFRESH();
            pg8::Gemm g{(const pg8::bf16_t*)(ws + WS_OAZB), (const pg8::bf16_t*)(ws + WS_WAB + l * SZ_WAB), Mrows, D, D, D / 2}; pg8::StaticOrder S; S.init(Mrows, D, F.G, (int)blockIdx.x);
            pg8::EpiMergeA E{(const pg8::bf16_t*)(ws + WS_P), (const pg8::bf16_t*)(ws + WS_YPART), (pg8::bf16_t*)(ws + WS_YPRE)};
            pg8::gemm_phase<pg8::EpiMergeA, pg8::StaticOrder, true, true>(F.lds + RING_OFF, g, S, E, F.tid);
            if (F.G == 256 && l == 0 && !(ap->flags & 32)) { P0Args A{INP(1), INP(3), INP(4), INP(6), INP(9), INP(10), INP(11), INP(12), INP(13)}; bg_convert(F, A, 32, BG_S2, BG_S3); }
        } SEAM(pb + 4);
        for (int rep_ = 0; rep_ < REPS(8); ++rep_) if (EN(8) && IN(pb + 5)) { if (rep_) GRID_BAR(); REFRESH();
            { pg8::Gemm g{(const pg8::bf16_t*)(ws + WS_YPRE), (const pg8::bf16_t*)(ws + WS_WO + l * SZ_WO), ML, D, D, D}; pg8::StaticOrder S; S.init(ML, D, F.G, (int)blockIdx.x);
              const float* xl = l == 0 ? INP(0) : (const float*)(ws + WS_X2);
              pg8::EpiRes E{xl, xl, MODL, 2 * D, (float*)(ws + WS_R), ALPHA};
              pg8::gemm_phase<pg8::EpiRes, pg8::StaticOrder, true, true>(F.lds + RING_OFF, g, S, E, F.tid); }
            if (!last) { pg8::Gemm g{(const pg8::bf16_t*)(ws + WS_YPRE) + (size_t)ML * D, (const pg8::bf16_t*)(ws + WS_WO + l * SZ_WO), MC, D, D, D / 8}; pg8::SplitOrder S; S.init(F.G, (int)blockIdx.x);
              pg8::EpiSlab E{(float*)(ws + WS_SLAB), (ap->flags & 512) ? 1 : 0};
              pg8::gemm_phase<pg8::EpiSlab, pg8::SplitOrder, true, true>(F.lds + RING_OFF, g, S, E, F.tid); }
        } SEAM(pb + 5);
        for (int rep_ = 0; rep_ < REPS(9); ++rep_) if (EN(9) && IN(pb + 6)) { if (rep_) GRID_BAR(); REFRESH();
            if (!last) phase_ln<true, true>(F, (const float*)(ws + WS_R), INP(14) + (size_t)(l * 2 + 0) * D, INP(15) + (size_t)(l * 2 + 0) * D, (float*)(ws + WS_X1), MR, MODL, 3 * D, 4 * D, (const float*)(ws + WS_SLAB), INP(2), MODL + 2 * NIN + 2 * D);
            else phase_ln<true, false>(F, (const float*)(ws + WS_R), INP(14) + (size_t)(l * 2 + 0) * D, INP(15) + (size_t)(l * 2 + 0) * D, (float*)(ws + WS_X1), ML, MODL, 3 * D, 4 * D, nullptr, nullptr, nullptr);
        } SEAM(pb + 6);
        for (int rep_ = 0; rep_ < REPS(10); ++rep_) if (EN(10) && IN(pb + 7)) { if (rep_) GRID_BAR(); REFRESH();
            pg8::Gemm g{(const pg8::bf16_t*)(ws + WS_U), (const pg8::bf16_t*)(ws + WS_WUP + l * SZ_WUP), Mrows, DFF, D, (ap->flags & 16) ? D / 4 : D}; pg8::StaticOrder S; S.init(Mrows, DFF, F.G, (int)blockIdx.x); if (ap->flags & 4) S.bmask = 0; if (ap->flags & 8) S.amask = 0;
            if (ap->flags & 128) { S.init(Mrows, DFF, F.G / 2, (int)blockIdx.x >> 1); if (blockIdx.x & 1) S.nwg = 0; }
            pg8::EpiStoreBf16<1> E{(pg8::bf16_t*)(ws + WS_H), DFF, (ap->flags & 64) ? 1 : 0};
            pg8::gemm_phase<pg8::EpiStoreBf16<1>, pg8::StaticOrder, true, true>(F.lds + RING_OFF, g, S, E, F.tid);
            if (F.G == 256 && l == 0 && !(ap->flags & 32)) { P0Args A{INP(1), INP(3), INP(4), INP(6), INP(9), INP(10), INP(11), INP(12), INP(13)}; bg_convert(F, A, 128, BG_S3, BG_S4); }
        } SEAM(pb + 7);
        for (int rep_ = 0; rep_ < REPS(11); ++rep_) if (EN(11) && IN(pb + 8)) { if (rep_) GRID_BAR(); REFRESH();
            { pg8::Gemm g{(const pg8::bf16_t*)(ws + WS_H), (const pg8::bf16_t*)(ws + WS_WDN + l * SZ_WDN), ML, D, DFF, DFF}; pg8::StaticOrder S; S.init(ML, D, F.G, (int)blockIdx.x);
              pg8::EpiRes E{(const float*)(ws + WS_X1), (const float*)(ws + WS_X1), MODL, 5 * D, (float*)(ws + WS_R), ALPHA};
              pg8::gemm_phase<pg8::EpiRes, pg8::StaticOrder, true, true>(F.lds + RING_OFF, g, S, E, F.tid); }
            if (!last && !(ap->flags & 256)) { pg8::Gemm g{(const pg8::bf16_t*)(ws + WS_H) + (size_t)ML * DFF, (const pg8::bf16_t*)(ws + WS_WDN + l * SZ_WDN), MC, D, DFF, DFF / 8}; pg8::SplitOrder S; S.init(F.G, (int)blockIdx.x);
              pg8::EpiSlab E{(float*)(ws + WS_SLAB), (ap->flags & 512) ? 1 : 0};
              pg8::gemm_phase<pg8::EpiSlab, pg8::SplitOrder, true, true>(F.lds + RING_OFF, g, S, E, F.tid); }
        } SEAM(pb + 8);
        for (int rep_ = 0; rep_ < REPS(12); ++rep_) if (EN(12) && IN(pb + 9)) { if (rep_) GRID_BAR(); REFRESH();
            if (!last) phase_ln<true, true>(F, (const float*)(ws + WS_R), INP(14) + (size_t)(l * 2 + 1) * D, INP(15) + (size_t)(l * 2 + 1) * D, (float*)(ws + WS_X2), MR, MODP + (size_t)(l + 1) * 3 * NIN, 0, D, (const float*)(ws + WS_SLAB), (const float*)(ws + WS_X1) + (size_t)ML * D, MODL + 2 * NIN + 5 * D);
            else phase_ln<false, false>(F, (const float*)(ws + WS_R), INP(14) + (size_t)(l * 2 + 1) * D, INP(15) + (size_t)(l * 2 + 1) * D, ap->out, ML, nullptr, 0, 0, nullptr, nullptr, nullptr);
        }
        if (!last) SEAM(pb + 9);
    }
#undef IN
#undef SEAM
}

extern "C" void kernel_launch(void* const* d_in, const int* in_sizes, int n_in, void* d_out, int out_size, void* d_ws, size_t ws_size, hipStream_t stream) {
    static int grid = 0;
    if (grid == 0) {
        if (n_in != 17 || in_sizes[0] != ML * D || out_size != ML * D || ws_size < WS_END) {
            fprintf(stderr, "kernel_launch: unexpected shapes (n_in %d, in0 %d, out %d, ws %zu < %zu); nothing launched\n", n_in, n_in > 0 ? in_sizes[0] : -1, out_size, ws_size, (size_t)WS_END); grid = -1; return; }
        int dev = 0, cus = 0, per_cu = 0;
        if (hipGetDevice(&dev) != hipSuccess || hipDeviceGetAttribute(&cus, hipDeviceAttributeMultiprocessorCount, dev) != hipSuccess) { fprintf(stderr, "kernel_launch: device query failed\n"); grid = -1; return; }
        if (hipFuncSetAttribute((const void*)mk_fwd, hipFuncAttributeMaxDynamicSharedMemorySize, LDS_BYTES) != hipSuccess) { fprintf(stderr, "kernel_launch: hipFuncSetAttribute failed\n"); grid = -1; return; }
        if (hipOccupancyMaxActiveBlocksPerMultiprocessor(&per_cu, (const void*)mk_fwd, NWAVES * 64, LDS_BYTES) != hipSuccess || per_cu < 1)
            fprintf(stderr, "kernel_launch: note: occupancy query reports %d workgroups per CU\n", per_cu);
        (void)hipGetLastError();
        grid = cus;
    }
    if (grid < 0) return;
    if (hipMemsetAsync((char*)d_ws + WS_CTL, 0, CTL_ZERO_BYTES, stream) != hipSuccess) { fprintf(stderr, "kernel_launch: memset failed\n"); return; }
    Args a{};
    for (int i = 0; i < 17; ++i) a.in[i] = (const float*)d_in[i];
    a.out = (float*)d_out; a.ws = (unsigned char*)d_ws;
#if MK_SPLIT
    for (int ph = 0; ph < N_PHASES; ++ph) { a.ph_lo = ph; a.ph_hi = ph + 1; hipLaunchKernelGGL(mk_fwd, dim3(grid), dim3(NWAVES * 64), LDS_BYTES, stream, a); }
#else
    a.ph_lo = 0; a.ph_hi = N_PHASES;
    hipLaunchKernelGGL(mk_fwd, dim3(grid), dim3(NWAVES * 64), LDS_BYTES, stream, a);
#if RT_RANGE
    for (int l = 0; l < 2; ++l) { (void)hipMemsetAsync((char*)d_ws + WS_CTL, 0, CTL_ZERO_BYTES, stream); a.ph_lo = 3 + 10 * l + PROBE_LO; a.ph_hi = 3 + 10 * l + PROBE_HI; a.flags = PROBE_FLAGS; hipLaunchKernelGGL(mk_fwd, dim3(grid), dim3(NWAVES * 64), LDS_BYTES, stream, a); }
#endif
#endif
    const hipError_t le = hipPeekAtLastError();
    if (le != hipSuccess) fprintf(stderr, "kernel_launch: launch failed: %s\n", hipGetErrorName(le));
}
```

```cpp
#include <hip/hip_runtime.h>
#include <cstdio>
#include <cstdint>

#ifndef MK_SPLIT
#define MK_SPLIT 0
#endif

namespace pg8 {
#define PG8_LAS __attribute__((address_space(3)))
typedef unsigned short bf16_t;
typedef short bf16x8 __attribute__((ext_vector_type(8)));
typedef float f32x4 __attribute__((ext_vector_type(4)));
typedef unsigned u32x4 __attribute__((ext_vector_type(4)));
constexpr int BM = 256, BK = 64, HALF = 128, HTB = HALF * BK * 2  , STAGE_BYTES = 8 * HTB, NXCD = 8, WGM = 8;

__host__ __device__ __forceinline__ int lds_byte(int r, int c) { const int st = (r >> 4) * 2 + (c >> 5), rr = r & 15, cc = c & 31, ob = rr * 64 + cc * 2; return st * 1024 + (ob ^ (((ob >> 9) & 1) << 5)); }
__host__ __device__ __forceinline__ void stage_rc(int b, int& R, int& C) { const int st = b / 1024, sb = b % 1024, swz = sb ^ (((sb >> 9) & 1) << 5); R = (st >> 1) * 16 + swz / 64; C = (st & 1) * 32 + (swz % 64) / 2; }
__host__ __device__ __forceinline__ int perm32(int rho) { const int n = rho >> 4, i = rho & 15; return 8 * (i >> 2) + 4 * n + (i & 3); }

struct Unit { int pm, pn, kc, am, bn; };
struct Gemm { const bf16_t* A; const bf16_t* Bt; int M, N, K, Kc; };

struct StaticOrder {
    int nM, nN, nwg, G, c, amask = -1, bmask = -1, kc0 = 0;
    __host__ __device__ void init(int M, int N, int G_, int c_) { nM = M / BM; nN = N / BM; nwg = nM * nN; G = G_; c = c_; }
    __host__ __device__ bool next(int i, Unit& u) const {
        const long L = (long)i * G + c; if (L >= nwg) return false;
        int wgid = (int)L; { const int q = nwg / NXCD, r = nwg % NXCD, xcd = wgid % NXCD, off = wgid / NXCD; wgid = (xcd < r ? xcd * (q + 1) : r * (q + 1) + (xcd - r) * q) + off; }
        const int nig = WGM * nN, gid = wgid / nig, fm = gid * WGM, gsz = (nM - fm) < WGM ? (nM - fm) : WGM;
        u.pm = fm + ((wgid % nig) % gsz); u.pn = (wgid % nig) / gsz; u.kc = kc0; u.am = u.pm & amask; u.bn = u.pn & bmask; return true;
    }
    __device__ __forceinline__ void a_ready(const Unit&) const {}
    __device__ __forceinline__ void done(const Unit&) const {}
};

__device__ __forceinline__ unsigned cvt_pk_bf16(float lo, float hi) { unsigned r; asm volatile("v_cvt_pk_bf16_f32 %0, %1, %2" : "=v"(r) : "v"(lo), "v"(hi)); return r; }
__device__ __forceinline__ float bf_lo(unsigned w) { return __uint_as_float(w << 16); }
__device__ __forceinline__ float bf_hi(unsigned w) { return __uint_as_float(w & 0xffff0000u); }

struct SplitOrder {
    int G, c;
    __host__ __device__ void init(int G_, int c_) { G = G_; c = c_; }
    __host__ __device__ bool next(int i, Unit& u) const { const int L = i * G + c; if (L >= 256) return false; u.kc = L & 7; const int t = L >> 3; u.pm = t & 1; u.pn = t >> 1; u.am = u.pm; u.bn = u.pn; return true; }
    __device__ __forceinline__ void a_ready(const Unit&) const {}
    __device__ __forceinline__ void done(const Unit&) const {}
};

template <int ACT  > struct EpiStoreBf16 {
    static constexpr bool PERM = true, AFTER_DRAIN = false, HAS_MID = false;
    bf16_t* O; int ldc; int skip;
    __device__ __forceinline__ void mid(f32x4 (&)[2][2][4][2], const Unit&, int, int, int, int) const {}
    __device__ __forceinline__ void operator()(f32x4 (&acc)[2][2][4][2], const Unit& u, int wr, int wc, int fr, int fq) const {
        if (skip) return;
        const int row0 = u.pm * BM + wr * 64 + fr, col0 = u.pn * BM + wc * 32 + 8 * fq;
#pragma unroll
        for (int ai = 0; ai < 2; ++ai)
#pragma unroll
            for (int m = 0; m < 4; ++m) { bf16_t* rowp = O + (size_t)(row0 + ai * HALF + m * 16) * ldc + col0;
#pragma unroll
                for (int bj = 0; bj < 2; ++bj) { f32x4 v0 = acc[ai][bj][m][0], v1 = acc[ai][bj][m][1];
                    if (ACT == 1) {
#pragma unroll
                        for (int j = 0; j < 4; ++j) { const float a = fmaxf(v0[j], 0.f), b = fmaxf(v1[j], 0.f); v0[j] = a * a; v1[j] = b * b; } }
                    u32x4 w; w.x = cvt_pk_bf16(v0[0], v0[1]); w.y = cvt_pk_bf16(v0[2], v0[3]); w.z = cvt_pk_bf16(v1[0], v1[1]); w.w = cvt_pk_bf16(v1[2], v1[3]);
                    *(u32x4*)(rowp + bj * HALF) = w; } }
    }
};
struct EpiRes {
    static constexpr bool PERM = false, AFTER_DRAIN = false, HAS_MID = false;
    const float* xlat; const float* xctx; const float* modl; int which; float* R; float alpha;
    __device__ __forceinline__ void mid(f32x4 (&)[2][2][4][2], const Unit&, int, int, int, int) const {}
    __device__ __forceinline__ void operator()(f32x4 (&acc)[2][2][4][2], const Unit& u, int wr, int wc, int fr, int fq) const {
        const int rl0 = wr * 64 + fr, col0 = u.pn * BM + wc * 32 + 4 * fq;
        const int vec = u.pm < 16 ? 0 : (u.pm < 32 ? 1 : 2);
        const float* g = modl + vec * 24576 + which + col0;
        const float* xb = (u.pm < 32 ? xlat + (size_t)u.pm * BM * 4096 : xctx + (size_t)(u.pm - 32) * BM * 4096) + col0;
        float* rb = R + (size_t)u.pm * BM * 4096 + col0;
        f32x4 gv[2][2];
#pragma unroll
        for (int bj = 0; bj < 2; ++bj)
#pragma unroll
            for (int n = 0; n < 2; ++n) gv[bj][n] = *(const f32x4*)(g + bj * HALF + n * 16);
#pragma unroll
        for (int ai = 0; ai < 2; ++ai)
#pragma unroll
            for (int m = 0; m < 4; ++m) { const size_t ro = (size_t)(rl0 + ai * HALF + m * 16) * 4096;
#pragma unroll
                for (int bj = 0; bj < 2; ++bj)
#pragma unroll
                    for (int n = 0; n < 2; ++n) { const f32x4 xs = *(const f32x4*)(xb + ro + bj * HALF + n * 16);
                        *(f32x4*)(rb + ro + bj * HALF + n * 16) = xs * alpha + gv[bj][n] * acc[ai][bj][m][n]; }
                asm volatile("" ::: "memory"); }
    }
};
struct EpiResLn {
    static constexpr bool PERM = false, AFTER_DRAIN = false, HAS_MID = false;
    const float* st; const float* lng; const float* lnb; const float* modl; int which; float* R; float alpha;
    __device__ __forceinline__ void mid(f32x4 (&)[2][2][4][2], const Unit&, int, int, int, int) const {}
    __device__ __forceinline__ void operator()(f32x4 (&acc)[2][2][4][2], const Unit& u, int wr, int wc, int fr, int fq) const {
        const int rl0 = wr * 64 + fr, col0 = u.pn * BM + wc * 32 + 4 * fq;
        const int vec = u.pm < 16 ? 0 : 1;
        const float* g = modl + vec * 24576 + which + col0;
        float* rb = R + (size_t)u.pm * BM * 4096 + col0;
        f32x4 gv[2][2];
        const float* sp = st + (size_t)(u.pm * BM + rl0) * 2;
#pragma unroll
        for (int bj = 0; bj < 2; ++bj)
#pragma unroll
            for (int n = 0; n < 2; ++n) gv[bj][n] = *(const f32x4*)(g + bj * HALF + n * 16);
#pragma unroll
        for (int ai = 0; ai < 2; ++ai)
#pragma unroll
            for (int m = 0; m < 4; ++m) { const size_t ro = (size_t)(rl0 + ai * HALF + m * 16) * 4096;
                const float mean = sp[(ai * HALF + m * 16) * 2], rs = sp[(ai * HALF + m * 16) * 2 + 1] * alpha;
                int c = col0; asm volatile("" : "+v"(c));
#pragma unroll
                for (int bj = 0; bj < 2; ++bj)
#pragma unroll
                    for (int n = 0; n < 2; ++n) { const f32x4 ro_ = *(const f32x4*)(rb + ro + bj * HALF + n * 16);
                        const f32x4 la = *(const f32x4*)(lng + c + bj * HALF + n * 16), lb = *(const f32x4*)(lnb + c + bj * HALF + n * 16);
                        *(f32x4*)(rb + ro + bj * HALF + n * 16) = (ro_ - mean) * rs * la + lb * alpha + gv[bj][n] * acc[ai][bj][m][n]; }
                asm volatile("" ::: "memory"); }
    }
};
struct EpiSlab {
    static constexpr bool PERM = false, AFTER_DRAIN = false, HAS_MID = false;
    float* slab; int skip;
    __device__ __forceinline__ void mid(f32x4 (&)[2][2][4][2], const Unit&, int, int, int, int) const {}
    __device__ __forceinline__ void operator()(f32x4 (&acc)[2][2][4][2], const Unit& u, int wr, int wc, int fr, int fq) const {
        if (skip) return;
        float* rb = slab + ((size_t)u.kc * 512 + (size_t)u.pm * BM + wr * 64 + fr) * 4096 + u.pn * BM + wc * 32 + 4 * fq;
#pragma unroll
        for (int ai = 0; ai < 2; ++ai)
#pragma unroll
            for (int m = 0; m < 4; ++m)
#pragma unroll
                for (int bj = 0; bj < 2; ++bj)
#pragma unroll
                    for (int n = 0; n < 2; ++n) *(f32x4*)(rb + (size_t)(ai * HALF + m * 16) * 4096 + bj * HALF + n * 16) = acc[ai][bj][m][n];
    }
};
struct EpiPartB {
    static constexpr bool PERM = true, AFTER_DRAIN = false, HAS_MID = false;
    const bf16_t* P; bf16_t* YP;
    __device__ __forceinline__ void mid(f32x4 (&)[2][2][4][2], const Unit&, int, int, int, int) const {}
    __device__ __forceinline__ void operator()(f32x4 (&acc)[2][2][4][2], const Unit& u, int wr, int wc, int fr, int fq) const {
        const int row0 = u.pm * BM + wr * 64 + fr, col0 = u.pn * BM + wc * 32 + 8 * fq;
#pragma unroll
        for (int ai = 0; ai < 2; ++ai)
#pragma unroll
            for (int m = 0; m < 4; ++m) { const size_t row = (size_t)(row0 + ai * HALF + m * 16);
#pragma unroll
                for (int bj = 0; bj < 2; ++bj) { const u32x4 gb = *(const u32x4*)(P + row * 24576 + 20480 + col0 + bj * HALF);
                    float o[8];
#pragma unroll
                    for (int w = 0; w < 4; ++w) {
                        const float s0 = __builtin_amdgcn_rcpf(1.f + __builtin_amdgcn_exp2f(-1.44269504f * bf_lo(gb[w]))), s1 = __builtin_amdgcn_rcpf(1.f + __builtin_amdgcn_exp2f(-1.44269504f * bf_hi(gb[w])));
                        o[2 * w] = acc[ai][bj][m][w >> 1][(w & 1) * 2] * s0; o[2 * w + 1] = acc[ai][bj][m][w >> 1][(w & 1) * 2 + 1] * s1; }
                    u32x4 wv; wv.x = cvt_pk_bf16(o[0], o[1]); wv.y = cvt_pk_bf16(o[2], o[3]); wv.z = cvt_pk_bf16(o[4], o[5]); wv.w = cvt_pk_bf16(o[6], o[7]);
                    *(u32x4*)(YP + row * 4096 + col0 + bj * HALF) = wv; }
                asm volatile("" ::: "memory"); }
    }
};
struct EpiMergeA {
    static constexpr bool PERM = true, AFTER_DRAIN = false, HAS_MID = false;
    const bf16_t* P; const bf16_t* YP; bf16_t* Y;
    __device__ __forceinline__ void mid(f32x4 (&)[2][2][4][2], const Unit&, int, int, int, int) const {}
    __device__ __forceinline__ void operator()(f32x4 (&acc)[2][2][4][2], const Unit& u, int wr, int wc, int fr, int fq) const {
        const int row0 = u.pm * BM + wr * 64 + fr, col0 = u.pn * BM + wc * 32 + 8 * fq;
#pragma unroll
        for (int ai = 0; ai < 2; ++ai)
#pragma unroll
            for (int m = 0; m < 4; ++m) { const size_t row = (size_t)(row0 + ai * HALF + m * 16);
#pragma unroll
                for (int bj = 0; bj < 2; ++bj) { const u32x4 ga = *(const u32x4*)(P + row * 24576 + 16384 + col0 + bj * HALF), yp = *(const u32x4*)(YP + row * 4096 + col0 + bj * HALF);
                    float o[8];
#pragma unroll
                    for (int w = 0; w < 4; ++w) {
                        const float s0 = __builtin_amdgcn_rcpf(1.f + __builtin_amdgcn_exp2f(-1.44269504f * bf_lo(ga[w]))), s1 = __builtin_amdgcn_rcpf(1.f + __builtin_amdgcn_exp2f(-1.44269504f * bf_hi(ga[w])));
                        o[2 * w] = acc[ai][bj][m][w >> 1][(w & 1) * 2] * s0 + bf_lo(yp[w]); o[2 * w + 1] = acc[ai][bj][m][w >> 1][(w & 1) * 2 + 1] * s1 + bf_hi(yp[w]); }
                    u32x4 wv; wv.x = cvt_pk_bf16(o[0], o[1]); wv.y = cvt_pk_bf16(o[2], o[3]); wv.z = cvt_pk_bf16(o[4], o[5]); wv.w = cvt_pk_bf16(o[6], o[7]);
                    *(u32x4*)(Y + row * 4096 + col0 + bj * HALF) = wv; }
                asm volatile("" ::: "memory"); }
    }
};

template <class Epi, class Sched, bool ALIGN_EPI = false, bool SP2 = false>
__device__ __forceinline__ void gemm_phase(PG8_LAS unsigned char* lds, const Gemm g, const Sched& S, const Epi& E, const int tid) {
    const int wid = __builtin_amdgcn_readfirstlane(tid >> 6), lane = tid & 63, wr = wid >> 2, wc = wid & 3, fr = lane & 15, fq = lane >> 4;
    const int K = g.K, nt = g.Kc / BK;
    unsigned voffA[2], voffB[2];
#pragma unroll
    for (int i = 0; i < 2; ++i) { int R, C; stage_rc(tid * 16 + i * 8192, R, C); const int Rb = Epi::PERM ? ((R & ~31) + perm32(R & 31)) : R;
        voffA[i] = (unsigned)(R * K + C) * 2u; voffB[i] = (unsigned)(Rb * BK + C) * 2u; }
    const size_t kstep = (size_t)(BK * 2);
    const size_t hstep = (size_t)HALF * K * 2;
    const size_t tstep = 2 * hstep;
    const size_t kstepB = (size_t)BM * BK * 2, hstepB = (size_t)HALF * BK * 2;
    const unsigned ldsw = (unsigned)wid * 1024u;
    const int aoff = lds_byte(wr * 64 + fr, fq * 8), boff = lds_byte(wc * 32 + fr, fq * 8);
#define PG8_SA(b, h) (((b) * 2 + (h)) * HTB)
#define PG8_SB(b, h) ((4 + (b) * 2 + (h)) * HTB)
#define PG8_STAGE(bufoff, gbase, voff) do { _Pragma("unroll") for (int _i = 0; _i < 2; ++_i) \
        __builtin_amdgcn_global_load_lds((const unsigned*)((const char*)(gbase) + (voff)[_i]), (PG8_LAS unsigned*)(lds + (bufoff) + ldsw + _i * 8192), 16, 0, 0); } while (0)
#define PG8_LDA(dst, b, h) do { _Pragma("unroll") for (int m = 0; m < 4; ++m) _Pragma("unroll") for (int k = 0; k < 2; ++k) dst[m][k] = *(const PG8_LAS bf16x8*)(lds + PG8_SA(b, h) + aoff + m * 2048 + k * 1024); } while (0)
#define PG8_LDB(dst, b, h) do { _Pragma("unroll") for (int n = 0; n < 2; ++n) _Pragma("unroll") for (int k = 0; k < 2; ++k) dst[n][k] = *(const PG8_LAS bf16x8*)(lds + PG8_SB(b, h) + boff + n * 2048 + k * 1024); } while (0)
#define PG8_MMA(ai, bj, At, Bt) do { __builtin_amdgcn_s_setprio(1); _Pragma("unroll") for (int m = 0; m < 4; ++m) _Pragma("unroll") for (int n = 0; n < 2; ++n) _Pragma("unroll") for (int k = 0; k < 2; ++k) \
        acc[ai][bj][m][n] = __builtin_amdgcn_mfma_f32_16x16x32_bf16(Bt[n][k], At[m][k], acc[ai][bj][m][n], 0, 0, 0); __builtin_amdgcn_s_setprio(0); } while (0)
#define PG8_WAIT_V(n) asm volatile("s_waitcnt vmcnt(" #n ")" ::: "memory")
#define PG8_WAIT_L(n) asm volatile("s_waitcnt lgkmcnt(" #n ")" ::: "memory")
#define PG8_BAR __builtin_amdgcn_s_barrier()
#define PG8_SCHED __builtin_amdgcn_sched_barrier(0)
    Unit cur, nxt; int ui = 0;
    if (!S.next(0, cur)) return;
    f32x4 acc[2][2][4][2];
#pragma unroll
    for (int a = 0; a < 2; ++a)
#pragma unroll
        for (int b = 0; b < 2; ++b)
#pragma unroll
            for (int m = 0; m < 4; ++m)
#pragma unroll
                for (int n = 0; n < 2; ++n) acc[a][b][m][n] = (f32x4){0.f, 0.f, 0.f, 0.f};
    bf16x8 At[4][2], B0[2][2], B1[2][2];
    const size_t cstep = (size_t)g.Kc * 2, cstepB = (size_t)(g.Kc / BK) * kstepB;
    const char* cA = (const char*)g.A + (size_t)cur.am * tstep + (size_t)cur.kc * cstep; const char* cB = (const char*)g.Bt + (size_t)cur.bn * tstep + (size_t)cur.kc * cstepB;
    S.a_ready(cur);
    if constexpr (SP2) {
        PG8_STAGE(PG8_SB(0, 0), cB, voffB); PG8_STAGE(PG8_SB(0, 1), cB + hstepB, voffB); PG8_STAGE(PG8_SA(0, 0), cA, voffA); PG8_STAGE(PG8_SA(0, 1), cA + hstep, voffA);
        if (wr == 1) PG8_BAR;
        PG8_WAIT_V(2); PG8_BAR;
        PG8_STAGE(PG8_SB(1, 0), cB + kstepB, voffB); PG8_STAGE(PG8_SA(1, 0), cA + kstep, voffA); PG8_STAGE(PG8_SB(1, 1), cB + hstepB + kstepB, voffB);
        PG8_WAIT_V(6); PG8_BAR;
    } else {
        PG8_STAGE(PG8_SB(0, 0), cB, voffB); PG8_STAGE(PG8_SA(0, 0), cA, voffA); PG8_STAGE(PG8_SB(0, 1), cB + hstepB, voffB); PG8_STAGE(PG8_SA(0, 1), cA + hstep, voffA);
        if (wr == 1) PG8_BAR;
        PG8_WAIT_V(4); PG8_BAR;
        PG8_STAGE(PG8_SB(1, 0), cB + kstepB, voffB); PG8_STAGE(PG8_SA(1, 0), cA + kstep, voffA); PG8_STAGE(PG8_SB(1, 1), cB + hstepB + kstepB, voffB);
        PG8_WAIT_V(6); PG8_BAR;
    }
    for (;;) {
        const bool has_next = S.next(ui + 1, nxt);
        const char* nA = has_next ? (const char*)g.A + (size_t)nxt.am * tstep + (size_t)nxt.kc * cstep : cA; const char* nB = has_next ? (const char*)g.Bt + (size_t)nxt.bn * tstep + (size_t)nxt.kc * cstepB : cB;
        for (int t = 0; t < nt; t += 2) {
            const bool last = (t == nt - 2);
            const char* a1 = cA + (size_t)(t + 1) * kstep;
            const char* a2 = last ? nA : cA + (size_t)(t + 2) * kstep; const char* b2 = last ? nB : cB + (size_t)(t + 2) * kstepB;
            const char* a3 = a2 + kstep; const char* b3 = b2 + kstepB;
            if (last && has_next) S.a_ready(nxt);
            if constexpr (Epi::HAS_MID) { if (t == (nt >> 1)) E.mid(acc, cur, wr, wc, fr, fq); }
            if constexpr (SP2) {
            PG8_LDB(B0, 0, 0); PG8_LDB(B1, 0, 1); PG8_SCHED; PG8_LDA(At, 0, 0); PG8_STAGE(PG8_SA(1, 1), a1 + hstep, voffA);
            PG8_WAIT_V(8); PG8_WAIT_L(0); PG8_BAR; PG8_MMA(0, 0, At, B0); PG8_MMA(0, 1, At, B1); PG8_BAR; PG8_SCHED;
            PG8_LDA(At, 0, 1); PG8_STAGE(PG8_SB(0, 0), b2, voffB); PG8_STAGE(PG8_SB(0, 1), b2 + hstepB, voffB); PG8_STAGE(PG8_SA(0, 0), a2, voffA);
            PG8_WAIT_V(8); PG8_WAIT_L(0); PG8_BAR; PG8_MMA(1, 0, At, B0); PG8_MMA(1, 1, At, B1); PG8_BAR; PG8_SCHED;
            PG8_LDB(B0, 1, 0); PG8_LDB(B1, 1, 1); PG8_SCHED; PG8_LDA(At, 1, 0); PG8_STAGE(PG8_SA(0, 1), a2 + hstep, voffA);
            PG8_WAIT_V(8); PG8_WAIT_L(0); PG8_BAR; PG8_MMA(0, 0, At, B0); PG8_MMA(0, 1, At, B1); PG8_BAR; PG8_SCHED;
            PG8_LDA(At, 1, 1); PG8_STAGE(PG8_SB(1, 0), b3, voffB); PG8_STAGE(PG8_SB(1, 1), b3 + hstepB, voffB); PG8_STAGE(PG8_SA(1, 0), a3, voffA);
            PG8_WAIT_V(8); PG8_WAIT_L(0); PG8_BAR; PG8_MMA(1, 0, At, B0); PG8_MMA(1, 1, At, B1); PG8_BAR; PG8_SCHED;
            } else {
            PG8_LDB(B0, 0, 0); PG8_SCHED; PG8_LDA(At, 0, 0); PG8_STAGE(PG8_SA(1, 1), a1 + hstep, voffA);
            PG8_WAIT_L(8); PG8_BAR; PG8_WAIT_L(0); PG8_MMA(0, 0, At, B0); PG8_BAR; PG8_SCHED;
            PG8_LDB(B1, 0, 1); PG8_STAGE(PG8_SB(0, 0), b2, voffB);
            PG8_BAR; PG8_WAIT_L(0); PG8_MMA(0, 1, At, B1); PG8_BAR;
            PG8_LDA(At, 0, 1); PG8_STAGE(PG8_SA(0, 0), a2, voffA);
            PG8_BAR; PG8_WAIT_L(0); PG8_MMA(1, 0, At, B0); PG8_BAR; PG8_SCHED;
            PG8_STAGE(PG8_SB(0, 1), b2 + hstepB, voffB);
            PG8_WAIT_V(6); PG8_BAR; PG8_MMA(1, 1, At, B1); PG8_BAR;
            PG8_LDB(B0, 1, 0); PG8_SCHED; PG8_LDA(At, 1, 0); PG8_STAGE(PG8_SA(0, 1), a2 + hstep, voffA);
            PG8_WAIT_L(8); PG8_BAR; PG8_WAIT_L(0); PG8_MMA(0, 0, At, B0); PG8_BAR; PG8_SCHED;
            PG8_LDB(B1, 1, 1); PG8_STAGE(PG8_SB(1, 0), b3, voffB);
            PG8_BAR; PG8_WAIT_L(0); PG8_MMA(0, 1, At, B1); PG8_BAR;
            PG8_LDA(At, 1, 1); PG8_STAGE(PG8_SA(1, 0), a3, voffA);
            PG8_BAR; PG8_WAIT_L(0); PG8_MMA(1, 0, At, B0); PG8_BAR; PG8_SCHED;
            PG8_STAGE(PG8_SB(1, 1), b3 + hstepB, voffB);
            PG8_WAIT_V(6); PG8_BAR; PG8_MMA(1, 1, At, B1); PG8_BAR;
            }
        }
        if constexpr (ALIGN_EPI) { if (wr == 0) PG8_BAR; }
        if constexpr (!Epi::AFTER_DRAIN) { E(acc, cur, wr, wc, fr, fq); S.done(cur); }
        if (!has_next) break;
#pragma unroll
        for (int a = 0; a < 2; ++a)
#pragma unroll
            for (int b = 0; b < 2; ++b)
#pragma unroll
                for (int m = 0; m < 4; ++m)
#pragma unroll
                    for (int n = 0; n < 2; ++n) acc[a][b][m][n] = (f32x4){0.f, 0.f, 0.f, 0.f};
        cur = nxt; cA = nA; cB = nB; ++ui;
        if constexpr (ALIGN_EPI) { if (wr == 1) PG8_BAR; }
    }
    PG8_WAIT_V(0);
    if constexpr (!ALIGN_EPI) { if (wr == 0) PG8_BAR; }
    PG8_BAR;
    if constexpr (Epi::AFTER_DRAIN) { E.fused(acc, cur, wr, wc, fr, fq, lds, wid, lane); S.done(cur); }
#undef PG8_SA
#undef PG8_SB
#undef PG8_STAGE
#undef PG8_LDA
#undef PG8_LDB
#undef PG8_MMA
#undef PG8_WAIT_V
#undef PG8_WAIT_L
#undef PG8_BAR
#undef PG8_SCHED
}
}

constexpr int NWAVES = 8;
constexpr int D = 4096, NBATCH = 2, SEQ = 4096, CTXL = 256, ML = NBATCH * SEQ  , MC = NBATCH * CTXL  , MR = ML + MC  ;
constexpr int NIN = 24576, DFF = 16384, WA = 2048, NHEAD = 16, DK = 128, NMOD = 6 * D, NKB = MR / 16  ;
constexpr int C_FF = 0, C_FB = 2048, C_I = 4096, C_Q = 6144, C_G = 8192, C_BG = 10240, C_CG = 12288, C_H = 14336, C_GA = 16384, C_GB = 20480;
constexpr float LN_EPS = 1e-5f, RMS_EPS = 1e-6f;
constexpr float ALPHA = 1.41421356237309515f;
constexpr int KSPLIT = 32;

constexpr size_t MiB = 1u << 20;
constexpr size_t WS_CTL = 0, CTL_ZERO_BYTES = 1 * MiB;
constexpr size_t WS_MOD = 1 * MiB;
constexpr size_t WS_ST = WS_MOD + 768 * 1024;
constexpr size_t WS_PART = 2 * MiB;
constexpr size_t WS_WIN = 20 * MiB, SZ_WIN = 192 * MiB;
constexpr size_t WS_WAB = 404 * MiB, SZ_WAB = 32 * MiB;
constexpr size_t WS_WO = 468 * MiB, SZ_WO = 32 * MiB;
constexpr size_t WS_WUP = 532 * MiB, SZ_WUP = 128 * MiB;
constexpr size_t WS_WDN = 788 * MiB, SZ_WDN = 128 * MiB;
constexpr size_t WS_U = 1044 * MiB;
constexpr size_t WS_P = 1112 * MiB;
constexpr size_t WS_QT = 1520 * MiB;
constexpr size_t WS_KBT = 1588 * MiB;
constexpr size_t WS_VT = 1656 * MiB;
constexpr size_t WS_ATT = 1690 * MiB;
constexpr size_t WS_EXPB = 1707 * MiB;
constexpr size_t WS_OF = 1716 * MiB;
constexpr size_t WS_OB = 1784 * MiB;
constexpr size_t WS_OAZB = 1852 * MiB;
constexpr size_t WS_YPRE = 1920 * MiB;
constexpr size_t WS_R = 1988 * MiB;
constexpr size_t WS_X1 = 2124 * MiB;
constexpr size_t WS_X2 = 2260 * MiB;
constexpr size_t WS_H = 2396 * MiB;
constexpr size_t WS_YPART = 2668 * MiB;
constexpr size_t WS_END = 2736 * MiB;
constexpr size_t WS_SLAB = WS_QT;
static_assert(WS_PART + (size_t)2 * KSPLIT * 3 * NIN * 4 <= WS_WIN && WS_WIN + 2 * SZ_WIN <= WS_WAB && WS_WAB + 2 * SZ_WAB <= WS_WO && WS_WO + 2 * SZ_WO <= WS_WUP && WS_WUP + 2 * SZ_WUP <= WS_WDN && WS_WDN + 2 * SZ_WDN <= WS_U, "ws map (weights)");
static_assert(WS_U + (size_t)MR * D * 2 <= WS_P && WS_P + (size_t)MR * NIN * 2 <= WS_QT && WS_QT + (size_t)NKB * 16 * 2 * 4096 <= WS_KBT && WS_KBT + (size_t)NKB * 16 * 2 * 4096 <= WS_VT && WS_VT + (size_t)NKB * 16 * 4096 <= WS_ATT, "ws map (act 1)");
static_assert(WS_ATT + (size_t)NKB * 16 * 2 * 1024 <= WS_EXPB && WS_EXPB + (size_t)NKB * 16 * 2 * 512 <= WS_OF && WS_OF + (size_t)MR * WA * 4 <= WS_OB && WS_OB + (size_t)MR * WA * 4 <= WS_OAZB && WS_OAZB + (size_t)MR * D * 2 <= WS_YPRE, "ws map (act 2)");
static_assert(WS_YPRE + (size_t)MR * D * 2 <= WS_R && WS_R + (size_t)MR * D * 4 <= WS_X1 && WS_X1 + (size_t)MR * D * 4 <= WS_X2 && WS_X2 + (size_t)MR * D * 4 <= WS_H && WS_H + (size_t)MR * DFF * 2 <= WS_END, "ws map (act 3)");
constexpr int CW_BAR = 4096;

constexpr int RING_OFF = 0, RING_BYTES = 131072;
constexpr int LDSCTL_OFF = RING_BYTES, MISC_OFF = LDSCTL_OFF + 320;
constexpr int LDS_BYTES = 147456;

#define GAS __attribute__((address_space(1)))
#define CAS __attribute__((address_space(4)))
#define LAS __attribute__((address_space(3)))
#define DI __device__ __forceinline__
typedef unsigned short bf16;
typedef unsigned v4u __attribute__((ext_vector_type(4)));
typedef unsigned v2u __attribute__((ext_vector_type(2)));
typedef float f32x4 __attribute__((ext_vector_type(4)));
typedef float f32x2 __attribute__((ext_vector_type(2)));
typedef float f32x16 __attribute__((ext_vector_type(16)));
typedef short bf16x8 __attribute__((ext_vector_type(8)));
typedef GAS unsigned gu32;
#define RLX_AGENT __ATOMIC_RELAXED, __HIP_MEMORY_SCOPE_AGENT
#define LDS_WAIT() asm volatile("s_waitcnt lgkmcnt(0)" ::: "memory")
#define VM_WAIT() asm volatile("s_waitcnt vmcnt(0)" ::: "memory")
#define MFMA32(a, b, c) __builtin_amdgcn_mfma_f32_32x32x16_bf16((a), (b), (c), 0, 0, 0)
DI unsigned f2bf(float f) { unsigned u = __builtin_bit_cast(unsigned, f); return (u + 0x7fffu + ((u >> 16) & 1u)) >> 16; }
typedef __bf16 bf16x2_t __attribute__((ext_vector_type(2)));
DI unsigned pk2(float lo, float hi) { const f32x2 v = {lo, hi}; return __builtin_bit_cast(unsigned, __builtin_convertvector(v, bf16x2_t)); }
DI float bflo(unsigned w) { return __uint_as_float(w << 16); }
DI float bfhi(unsigned w) { return __uint_as_float(w & 0xffff0000u); }
constexpr float L2E = 1.44269504088896341f;
DI float ex2(float x) { return __builtin_amdgcn_exp2f(x); }
DI float sigmoidf_(float x) { return __builtin_amdgcn_rcpf(1.f + ex2(-L2E * x)); }
DI int sigma16(int p) { return 8 * ((p >> 2) & 1) + 4 * (p >> 3) + (p & 3); }

#define XB_TMO      128
#define XB_XCNT(j)  (256  + 64 * (j))
#define XB_XSUB(j)  (1280 + 64 * (j))
#define XB_XGEN(j)  (2304 + 64 * (j))
#define XB_TOP      3328
#define XB_TOPGEN   3392
#define XCD_BAR_WORDS 3456
#define XB_SPIN_CAP (1u << 18)

__device__ __forceinline__ unsigned xb_ld(unsigned* p)              { return __hip_atomic_load(p, __ATOMIC_RELAXED, __HIP_MEMORY_SCOPE_AGENT); }
__device__ __forceinline__ unsigned xb_add(unsigned* p, unsigned v) { return __hip_atomic_fetch_add(p, v, __ATOMIC_RELAXED, __HIP_MEMORY_SCOPE_AGENT); }
__device__ __forceinline__ unsigned xb_xcc_id() { return (unsigned)__builtin_amdgcn_s_getreg((3 << 11) | 20) & 0xFu; }
#define XB_SPIN(cond, bar) do { unsigned _sp = 0; while (cond) { __builtin_amdgcn_s_sleep(1); \
    if ((++_sp & 255u) == 0u) { if (xb_ld(&(bar)[XB_TMO])) break; if (_sp > XB_SPIN_CAP) { atomicAdd(&(bar)[XB_TMO], 1u); break; } } } } while (0)

struct XcdBarrier {
    unsigned* bar; unsigned x;
    volatile LAS unsigned* st;
};

__device__ __forceinline__ XcdBarrier xcd_barrier_post(unsigned* bar, volatile LAS unsigned* st) {
    XcdBarrier b; b.bar = bar; b.x = xb_xcc_id(); b.st = st;
    if (threadIdx.x == 0) (void)xb_add(&bar[XB_XCNT(b.x)], 1u);
    return b;
}
__device__ __forceinline__ void xcd_barrier_complete(unsigned* bar, unsigned x, unsigned& nloc, unsigned& nx) {
    const unsigned G = gridDim.x * gridDim.y * gridDim.z;
    unsigned sum, cnt, mine, sp = 0u;
    for (;;) {
        sum = 0u; cnt = 0u; mine = 0u;
#pragma unroll
        for (unsigned j = 0; j < 16; ++j) { const unsigned c = xb_ld(&bar[XB_XCNT(j)]); sum += c; cnt += (c > 0u) ? 1u : 0u; mine = (j == x) ? c : mine; }
        if (sum == G) break;
        __builtin_amdgcn_s_sleep(1);
        if ((++sp & 255u) == 0u) { if (xb_ld(&bar[XB_TMO])) break; if (sp > XB_SPIN_CAP) { atomicAdd(&bar[XB_TMO], 1u); break; } }
    }
    nloc = mine > 0u ? mine : 1u; nx = cnt > 0u ? cnt : 1u;
}

__device__ __forceinline__ void xcd_barrier(const XcdBarrier& b) {
    asm volatile("s_waitcnt vmcnt(0)" ::: "memory");
    __syncthreads();
    if (threadIdx.x == 0) {
        unsigned* bar = b.bar;
        unsigned bx = b.x; asm volatile("" : "+s"(bx));
        __builtin_amdgcn_s_waitcnt(0);
        unsigned nloc = b.st[0], nx = b.st[1];
        if (nloc == 0u) { xcd_barrier_complete(bar, bx, nloc, nx); b.st[0] = nloc; b.st[1] = nx; }
        const unsigned old = xb_add(&bar[XB_XSUB(bx)], 1u);
        const unsigned gen = old / nloc;
        if (old + 1u == (gen + 1u) * nloc) {
            __builtin_amdgcn_fence(__ATOMIC_RELEASE, "agent");
            asm volatile("s_waitcnt vmcnt(0)" ::: "memory");
            const unsigned og = xb_add(&bar[XB_TOP], 1u);
            const unsigned tg = og / nx;
            if (og + 1u == (tg + 1u) * nx) xb_add(&bar[XB_TOPGEN], 1u);
            else XB_SPIN(xb_ld(&bar[XB_TOPGEN]) == tg, bar);
            __builtin_amdgcn_fence(__ATOMIC_ACQUIRE, "agent");
            xb_add(&bar[XB_XGEN(bx)], 1u);
            asm volatile("s_waitcnt vmcnt(0)" ::: "memory");
        } else {
            XB_SPIN(xb_ld(&bar[XB_XGEN(bx)]) == gen, bar);
            __builtin_amdgcn_fence(__ATOMIC_ACQUIRE, "agent");
            asm volatile("s_waitcnt vmcnt(0)" ::: "memory");
        }
    }
    __syncthreads();
}

struct Frame {
    LAS unsigned char* lds;
    volatile LAS unsigned* MISC;
    gu32* ctl;
    int tid, lane, wave;
    int G;
    unsigned char* ws;
};
DI float shfl_x(float v, int o, int lane) { return __int_as_float(__builtin_amdgcn_ds_bpermute((lane ^ o) << 2, __float_as_int(v))); }
DI float wave_sum(float v) {
#pragma unroll
    for (int o = 1; o < 64; o <<= 1) v += __shfl_xor(v, o);
    return v;
}
DI int row_vec(int row) { return row < SEQ ? 0 : (row < ML ? 1 : 2); }

struct P0Item { const float* src; bf16* dst; int N; };
DI void p0_load(const P0Item& it, int lane, f32x4 (&v)[8]) {
#pragma unroll
    for (int i = 0; i < 8; ++i) v[i] = *(const GAS f32x4*)(it.src + (size_t)(8 * i + (lane >> 3)) * it.N + (lane & 7) * 4);
}
DI void p0_emit(const P0Item& it, const f32x4 (&v)[8], LAS float* scr, int lane) {
#pragma unroll
    for (int i = 0; i < 8; ++i) { LAS float* w = scr + (8 * i + (lane >> 3)) * 33 + (lane & 7) * 4; w[0] = v[i][0]; w[1] = v[i][1]; w[2] = v[i][2]; w[3] = v[i][3]; }
    LDS_WAIT(); asm volatile("" ::: "memory");
#pragma unroll
    for (int jj = 0; jj < 4; ++jj) { const int q = 64 * jj + lane, n = q >> 3, c = q & 7; const LAS float* s = scr + (8 * c) * 33 + n;
        v4u o; o.x = pk2(s[0 * 33], s[1 * 33]); o.y = pk2(s[2 * 33], s[3 * 33]); o.z = pk2(s[4 * 33], s[5 * 33]); o.w = pk2(s[6 * 33], s[7 * 33]);
        *(GAS v4u*)(it.dst + (size_t)q * 8) = o; }
    LDS_WAIT(); asm volatile("" ::: "memory");
}
struct P0Args { const float *c, *c_ctx, *w_ada, *w_in, *w_out_a, *w_out_b, *w_o, *w_up, *w_down; };
constexpr int I_IN = (D / 64) * (NIN / 32), I_OA = (WA / 64) * (D / 32), I_O = (D / 64) * (D / 32), I_UP = (D / 64) * (DFF / 32), I_DN = (DFF / 64) * (D / 32);
constexpr int I_LAYER = I_IN + 2 * I_OA + I_O + I_UP + I_DN;
constexpr int BG_N1 = 9600  , BG_N3 = 15680  , BG_N4 = 19200  , BG_N5 = 9600  ;
constexpr int BG_S0 = I_LAYER - (BG_N1 + BG_N3 + BG_N4 + BG_N5);
constexpr int BG_S1 = BG_S0 + BG_N1, BG_S2 = BG_S1, BG_S3 = BG_S2 + BG_N3, BG_S4 = BG_S3 + BG_N4, BG_S5 = BG_S4 + BG_N5;
static_assert(BG_S0 >= I_IN && BG_S5 == I_LAYER, "layer 1's w_in is converted in the prologue (the last slot runs inside layer 1's w_in phase); the slots end the layer");
DI void convert_items(Frame& F, const P0Args& A, int lo, int hi, int gw, int NGW, LAS float* scr) {
    auto decode = [&](int itn, P0Item& o) {
        const int l = itn / I_LAYER; int r = itn % I_LAYER;
        const float* W; bf16* WT; int N, Ktot, koff = 0;
        if (r < I_IN) { W = A.w_in + (size_t)l * D * NIN; WT = (bf16*)(F.ws + WS_WIN + l * SZ_WIN); N = NIN; Ktot = D; }
        else if ((r -= I_IN) < I_OA) { W = A.w_out_a + (size_t)l * WA * D; WT = (bf16*)(F.ws + WS_WAB + l * SZ_WAB); N = D; Ktot = D; }
        else if ((r -= I_OA) < I_OA) { W = A.w_out_b + (size_t)l * WA * D; WT = (bf16*)(F.ws + WS_WAB + l * SZ_WAB); N = D; Ktot = D; koff = WA; }
        else if ((r -= I_OA) < I_O) { W = A.w_o + (size_t)l * D * D; WT = (bf16*)(F.ws + WS_WO + l * SZ_WO); N = D; Ktot = D; }
        else if ((r -= I_O) < I_UP) { W = A.w_up + (size_t)l * D * DFF; WT = (bf16*)(F.ws + WS_WUP + l * SZ_WUP); N = DFF; Ktot = D; }
        else { r -= I_UP; W = A.w_down + (size_t)l * DFF * D; WT = (bf16*)(F.ws + WS_WDN + l * SZ_WDN); N = D; Ktot = DFF; }
        const int nblk = N / 32, kb = r / nblk, nb = r % nblk, k0 = 64 * kb, n0 = 32 * nb;
        o.src = W + (size_t)k0 * N + n0; o.N = N;
        o.dst = WT + (((size_t)(n0 >> 8) * (Ktot / 64) + ((koff + k0) >> 6)) * 256 + (n0 & 255)) * 64;
    };
    int itn = lo + gw; P0Item ia, ib; f32x4 va[8], vb[8];
    if (itn < hi) { decode(itn, ia); p0_load(ia, F.lane, va); }
    while (itn < hi) {
        const int i2 = itn + NGW; if (i2 < hi) { decode(i2, ib); p0_load(ib, F.lane, vb); }
        p0_emit(ia, va, scr, F.lane);
        if (i2 >= hi) break;
        const int i3 = i2 + NGW; if (i3 < hi) { decode(i3, ia); p0_load(ia, F.lane, va); }
        p0_emit(ib, vb, scr, F.lane);
        itn = i3;
    }
}
DI void bg_convert(Frame& F, const P0Args& A, int wg0, int lo, int hi) {
    if ((int)blockIdx.x < wg0) return;
    const int gw = ((int)blockIdx.x - wg0) * NWAVES + F.wave, NGW = (F.G - wg0) * NWAVES;
    convert_items(F, A, I_LAYER + lo, I_LAYER + hi, gw, NGW, (LAS float*)(F.lds + RING_OFF + F.wave * 16384));
}
DI void phase0(Frame& F, const P0Args& A) {
    LAS float* sv = (LAS float*)(F.lds + RING_OFF);
    for (int i = F.tid; i < 3 * D; i += NWAVES * 64) { const int v = i / D, k = i % D; const float x = v < 2 ? A.c[v * D + k] : A.c_ctx[k]; sv[i] = x * sigmoidf_(x); }
    __syncthreads();
    const int gw = blockIdx.x * NWAVES + F.wave, NGW = F.G * NWAVES;
    float* part = (float*)(F.ws + WS_PART);
    constexpr int NCG = NIN / 256, NTASK = 2 * KSPLIT * NCG;
    for (int tk = gw; tk < NTASK; tk += NGW) {
        const int l = tk / (KSPLIT * NCG), rem = tk % (KSPLIT * NCG), kc = rem / NCG, cg = rem % NCG;
        const int n0 = cg * 256 + F.lane * 4, k0 = kc * (D / KSPLIT);
        const float* wp = A.w_ada + ((size_t)l * D + k0) * NIN + n0;
        f32x4 a0 = {0.f, 0.f, 0.f, 0.f}, a1 = a0, a2 = a0;
#pragma unroll 8
        for (int k = 0; k < D / KSPLIT; ++k) { const f32x4 w = *(const GAS f32x4*)(wp + (size_t)k * NIN);
            a0 += w * sv[k0 + k]; a1 += w * sv[D + k0 + k]; a2 += w * sv[2 * D + k0 + k]; }
        float* pp = part + ((size_t)(l * KSPLIT + kc) * 3) * NIN + n0;
        *(f32x4*)(pp) = a0; *(f32x4*)(pp + NIN) = a1; *(f32x4*)(pp + 2 * NIN) = a2;
    }
    __syncthreads();
    convert_items(F, A, 0, I_LAYER, gw, NGW, (LAS float*)(F.lds + RING_OFF + F.wave * 16384));
    convert_items(F, A, I_LAYER, I_LAYER + BG_S0, gw, NGW, (LAS float*)(F.lds + RING_OFF + F.wave * 16384));
}
DI void phase1(Frame& F, const float* b_ada) {
    const float* part = (const float*)(F.ws + WS_PART); float* mod = (float*)(F.ws + WS_MOD);
    for (int i = blockIdx.x * (NWAVES * 64) + F.tid; i < 2 * 3 * NIN; i += F.G * NWAVES * 64) {
        const int l = i / (3 * NIN), rem = i % (3 * NIN), v = rem / NIN, n = rem % NIN;
        float s = b_ada[l * NIN + n];
#pragma unroll 8
        for (int kc = 0; kc < KSPLIT; ++kc) s += part[((size_t)(l * KSPLIT + kc) * 3 + v) * NIN + n];
        mod[i] = s;
    }
}
DI void phase_modulate0(Frame& F, const float* x, const float* ctx) {
    const float* mod = (const float*)(F.ws + WS_MOD); bf16* U = (bf16*)(F.ws + WS_U);
    const int gw = blockIdx.x * NWAVES + F.wave, NGW = F.G * NWAVES;
    for (int row = gw; row < MR; row += NGW) {
        const float* xr = row < ML ? x + (size_t)row * D : ctx + (size_t)(row - ML) * D;
        const float* mv = mod + row_vec(row) * NIN;
        bf16* ur = U + (size_t)row * D;
#pragma unroll 4
        for (int j = 0; j < 16; ++j) { const int c = j * 256 + F.lane * 4;
            const f32x4 v = *(const GAS f32x4*)(xr + c), sh = *(const f32x4*)(mv + c), sc = *(const f32x4*)(mv + D + c);
            const f32x4 o = v * (sc + 1.f) + sh; v2u w; w.x = pk2(o[0], o[1]); w.y = pk2(o[2], o[3]); *(GAS v2u*)(ur + c) = w; }
    }
}
template <bool HAS_MOD, bool CTX_SPLIT>
DI void phase_ln(Frame& F, const float* R, const float* g, const float* b, float* xo, int xo_from  , float* st  , int nrows, const float* mv_base  , int sh_off, int sc_off,
                 const float* slab  , const float* xres_ctx  , const float* gate_ctx  ) {
    bf16* U = (bf16*)(F.ws + WS_U);
    LAS float* red1 = (LAS float*)(F.lds + RING_OFF); LAS float* red2 = red1 + 64;
    const int nlat = CTX_SPLIT ? ML / F.G : 0, nctx = CTX_SPLIT ? MC / F.G : 0;
    const int rpw = CTX_SPLIT ? nlat + nctx : (nrows + F.G - 1) / F.G, row0 = blockIdx.x * rpw;
#define LN_ROW(k) (CTX_SPLIT ? ((k) < nlat ? (int)blockIdx.x * nlat + (k) : ML + (int)blockIdx.x * nctx + ((k) - nlat)) : row0 + (k))
    const int c0 = F.wave * 512 + F.lane * 8;
    f32x4 gc0 = {0.f, 0.f, 0.f, 0.f}, gc1 = gc0;
    if (CTX_SPLIT) { gc0 = *(const f32x4*)(gate_ctx + c0); gc1 = *(const f32x4*)(gate_ctx + c0 + 4); }
    const f32x4 g0 = *(const f32x4*)(g + c0), g1 = *(const f32x4*)(g + c0 + 4), b0 = *(const f32x4*)(b + c0), b1 = *(const f32x4*)(b + c0 + 4);
    f32x4 sc0 = {0.f, 0.f, 0.f, 0.f}, sc1 = sc0, sh0 = sc0, sh1 = sc0; int cur_vec = -1;
    auto ln_load = [&](int rb, f32x4 (&v)[8][2]) {
#pragma unroll
        for (int i = 0; i < 8; ++i) { const int row = LN_ROW(rb + i); const bool ok = (rb + i < rpw) && row < nrows;
            if (ok && CTX_SPLIT && row >= ML) { const size_t ro = (size_t)(row - ML) * D + c0;
                f32x4 a0 = *(const GAS f32x4*)(slab + ro), a1 = *(const GAS f32x4*)(slab + ro + 4);
#pragma unroll
                for (int kc = 1; kc < 8; ++kc) { a0 += *(const GAS f32x4*)(slab + (size_t)kc * MC * D + ro); a1 += *(const GAS f32x4*)(slab + (size_t)kc * MC * D + ro + 4); }
                v[i][0] = *(const GAS f32x4*)(xres_ctx + ro) * ALPHA + gc0 * a0; v[i][1] = *(const GAS f32x4*)(xres_ctx + ro + 4) * ALPHA + gc1 * a1; }
            else if (ok) { const float* rr = R + (size_t)row * D + c0; v[i][0] = *(const GAS f32x4*)rr; v[i][1] = *(const GAS f32x4*)(rr + 4); }
            else { v[i][0] = (f32x4){0.f, 0.f, 0.f, 0.f}; v[i][1] = v[i][0]; } }
    };
    auto ln_process = [&](int rb, f32x4 (&v)[8][2]) {
        float s[8];
#pragma unroll
        for (int i = 0; i < 8; ++i) s[i] = ((v[i][0][0] + v[i][0][1]) + (v[i][0][2] + v[i][0][3])) + ((v[i][1][0] + v[i][1][1]) + (v[i][1][2] + v[i][1][3]));
#pragma unroll
        for (int o = 1; o < 64; o <<= 1) {
#pragma unroll
            for (int i = 0; i < 8; ++i) s[i] += shfl_x(s[i], o, F.lane); }
        if (F.lane < 8) { float t = s[0];
#pragma unroll
            for (int i = 1; i < 8; ++i) t = F.lane == i ? s[i] : t;
            red1[F.lane * 8 + F.wave] = t; }
        __syncthreads();
        float mean[8];
#pragma unroll
        for (int i = 0; i < 8; ++i) { const f32x4 p0 = *(const LAS f32x4*)(red1 + i * 8), p1 = *(const LAS f32x4*)(red1 + i * 8 + 4);
            mean[i] = (((p0[0] + p0[1]) + (p0[2] + p0[3])) + ((p1[0] + p1[1]) + (p1[2] + p1[3]))) * (1.f / D); }
#pragma unroll
        for (int i = 0; i < 8; ++i) { v[i][0] = v[i][0] - mean[i]; v[i][1] = v[i][1] - mean[i];
            s[i] = ((v[i][0][0] * v[i][0][0] + v[i][0][1] * v[i][0][1]) + (v[i][0][2] * v[i][0][2] + v[i][0][3] * v[i][0][3])) + ((v[i][1][0] * v[i][1][0] + v[i][1][1] * v[i][1][1]) + (v[i][1][2] * v[i][1][2] + v[i][1][3] * v[i][1][3])); }
#pragma unroll
        for (int o = 1; o < 64; o <<= 1) {
#pragma unroll
            for (int i = 0; i < 8; ++i) s[i] += shfl_x(s[i], o, F.lane); }
        if (F.lane < 8) { float t = s[0];
#pragma unroll
            for (int i = 1; i < 8; ++i) t = F.lane == i ? s[i] : t;
            red2[F.lane * 8 + F.wave] = t; }
        __syncthreads();
#pragma unroll
        for (int i = 0; i < 8; ++i) { const int row = LN_ROW(rb + i); const bool ok = (rb + i < rpw) && row < nrows;
            const f32x4 p0 = *(const LAS f32x4*)(red2 + i * 8), p1 = *(const LAS f32x4*)(red2 + i * 8 + 4);
            const float var = (((p0[0] + p0[1]) + (p0[2] + p0[3])) + ((p1[0] + p1[1]) + (p1[2] + p1[3]))) * (1.f / D);
            const float rstd = 1.f / sqrtf(var + LN_EPS);
            if (ok) {
                const f32x4 y0 = v[i][0] * rstd * g0 + b0, y1 = v[i][1] * rstd * g1 + b1;
                if (row >= xo_from) { float* xr = xo + (size_t)row * D + c0; *(GAS f32x4*)xr = y0; *(GAS f32x4*)(xr + 4) = y1; }
                if (st && F.tid == 0) *(GAS f32x2*)(st + (size_t)row * 2) = (f32x2){mean[i], rstd};
                if (HAS_MOD) { const int vec = row_vec(row);
                    if (vec != cur_vec) { const float* mv = mv_base + vec * NIN + c0; sc0 = *(const f32x4*)(mv + sc_off); sc1 = *(const f32x4*)(mv + sc_off + 4); sh0 = *(const f32x4*)(mv + sh_off); sh1 = *(const f32x4*)(mv + sh_off + 4); cur_vec = vec; }
                    const f32x4 o0 = y0 * (sc0 + 1.f) + sh0, o1 = y1 * (sc1 + 1.f) + sh1;
                    v4u w; w.x = pk2(o0[0], o0[1]); w.y = pk2(o0[2], o0[3]); w.z = pk2(o1[0], o1[1]); w.w = pk2(o1[2], o1[3]);
                    *(GAS v4u*)(U + (size_t)row * D + c0) = w; } } }
    };
    f32x4 va[8][2], vb[8][2];
    ln_load(0, va);
    for (int rb = 0; rb < rpw; rb += 16) {
        if (rb + 8 < rpw) ln_load(rb + 8, vb);
        ln_process(rb, va);
        if (rb + 8 >= rpw) break;
        if (rb + 16 < rpw) ln_load(rb + 16, va);
        ln_process(rb + 8, vb);
    }
    __syncthreads();
#undef LN_ROW
}
DI void prep_task(Frame& F, const bf16* P, const float* lbnd  , int layer, int kb, int head, LAS unsigned char* wl  , int nost  ) {
    const int lane = F.lane;
    const bf16* prow = P + (size_t)(16 * kb) * NIN + head * DK + 2 * lane;
    unsigned zf[16], zb[16], qq[16], vv[16];
#pragma unroll
    for (int t = 0; t < 16; ++t) { const bf16* pr = prow + (size_t)t * NIN;
        zf[t] = *(const GAS unsigned*)(pr + C_FF); zb[t] = *(const GAS unsigned*)(pr + C_FB); qq[t] = *(const GAS unsigned*)(pr + C_Q); vv[t] = *(const GAS unsigned*)(pr + C_I); }
    const size_t kh = (size_t)kb * 16 + head;
    {
        unsigned lo[8], hi[8];
#pragma unroll
        for (int m = 0; m < 8; ++m) { const int s0 = sigma16(2 * m); lo[m] = (vv[s0] & 0xffffu) | (vv[s0 + 1] << 16); hi[m] = (vv[s0] >> 16) | (vv[s0 + 1] & 0xffff0000u); }
        GAS v4u* o = (GAS v4u*)(F.ws + WS_VT + kh * 4096 + (size_t)(2 * lane) * 32);
        if (!nost) { o[0] = (v4u){lo[0], lo[1], lo[2], lo[3]}; o[1] = (v4u){lo[4], lo[5], lo[6], lo[7]}; o[2] = (v4u){hi[0], hi[1], hi[2], hi[3]}; o[3] = (v4u){hi[4], hi[5], hi[6], hi[7]}; }
    }
    float qs0[16], qs1[16];
#pragma unroll
    for (int t = 0; t < 16; ++t) { const float a = bflo(qq[t]), b = bfhi(qq[t]); qs0[t] = a * sigmoidf_(a); qs1[t] = b * sigmoidf_(b); }
    LAS unsigned char* lq = wl; LAS unsigned char* lk = wl + 16 * 272;
    const int d0 = 2 * lane, dpos = 16 * (d0 >> 4) + sigma16(d0 & 15);
    const int dl = d0 & 31, epos = (d0 >> 5) * 32 + ((dl >> 2) & 1) * 16 + ((dl & 3) | ((dl >> 3) << 2));
#pragma unroll
    for (int dir = 0; dir < 2; ++dir) {
        const size_t idx = kh * 2 + dir;
        float lb0 = 0.f, lb1 = 0.f;
        if (layer == 1) { const float* lp = lbnd + dir * WA + head * DK + d0;
            lb0 = __builtin_amdgcn_rcpf(1.f + ex2(L2E * (lp[0] - lp[2 * WA]))); lb1 = __builtin_amdgcn_rcpf(1.f + ex2(L2E * (lp[1] - lp[2 * WA + 1]))); }
        float b0[16], b1[16], k0[16], k1[16]; float c0 = 0.f, c1 = 0.f;
#pragma unroll
        for (int i = 0; i < 16; ++i) { const int t = dir ? 15 - i : i; const unsigned zw = dir ? zb[t] : zf[t];
            const float z0 = bflo(zw), z1 = bfhi(zw);
            const float e0 = ex2(-L2E * fabsf(z0)), e1 = ex2(-L2E * fabsf(z1)), r0 = __builtin_amdgcn_rcpf(1.f + e0), r1 = __builtin_amdgcn_rcpf(1.f + e1);
            const float sp0 = z0 >= 0.f ? r0 : e0 * r0, sm0 = z0 >= 0.f ? e0 * r0 : r0, sp1 = z1 >= 0.f ? r1 : e1 * r1, sm1 = z1 >= 0.f ? e1 * r1 : r1;
            c0 += __builtin_amdgcn_logf(fmaxf(lb0 + (1.f - lb0) * sp0, 1e-37f)); c1 += __builtin_amdgcn_logf(fmaxf(lb1 + (1.f - lb1) * sp1, 1e-37f));
            b0[t] = c0; b1[t] = c1; k0[t] = (1.f - lb0) * sm0; k1[t] = (1.f - lb1) * sm1; }
        float kb0[16], kb1[16];
#pragma unroll
        for (int t = 0; t < 16; ++t) {
            const float eb0 = ex2(b0[t]), eb1 = ex2(b1[t]);
            const unsigned qt = pk2(qs0[t] * eb0, qs1[t] * eb1);
            const unsigned kt = pk2(k0[t] * ex2(fminf(-b0[t], 115.f)), k1[t] * ex2(fminf(-b1[t], 115.f)));
            kb0[t] = k0[t] * ex2(c0 - b0[t]); kb1[t] = k1[t] * ex2(c1 - b1[t]);
            *(LAS unsigned*)(lq + t * 272 + 4 * lane) = qt; *(LAS unsigned*)(lk + t * 272 + 4 * lane) = kt;
            if (!nost) *(GAS unsigned*)(F.ws + WS_QT + idx * 4096 + (size_t)t * 256 + dpos * 2) = qt; }
        {
            unsigned w0[8], w1[8];
#pragma unroll
            for (int m = 0; m < 8; ++m) { const int s0 = sigma16(2 * m); w0[m] = pk2(kb0[s0], kb0[s0 + 1]); w1[m] = pk2(kb1[s0], kb1[s0 + 1]); }
            GAS v4u* o = (GAS v4u*)(F.ws + WS_KBT + idx * 4096 + (size_t)d0 * 32);
            if (!nost) { o[0] = (v4u){w0[0], w0[1], w0[2], w0[3]}; o[1] = (v4u){w0[4], w0[5], w0[6], w0[7]}; o[2] = (v4u){w1[0], w1[1], w1[2], w1[3]}; o[3] = (v4u){w1[4], w1[5], w1[6], w1[7]}; }
        }
        if (!nost) *(GAS f32x2*)(F.ws + WS_EXPB + idx * 512 + (size_t)epos * 4) = (f32x2){ex2(c0), ex2(c1)};
        LDS_WAIT(); asm volatile("" ::: "memory");
        const int r = lane & 31, hh = lane >> 5;
        f32x16 X;
#pragma unroll
        for (int i = 0; i < 16; ++i) X[i] = 0.f;
#pragma unroll
        for (int ks = 0; ks < 8; ++ks) { const int off = (r & 15) * 272 + (16 * ks + 8 * hh) * 2;
            const bf16x8 ak = *(const LAS bf16x8*)(lk + off), bq = *(const LAS bf16x8*)(lq + off); X = MFMA32(ak, bq, X); }
        unsigned aw[4];
#pragma unroll
        for (int w = 0; w < 4; ++w) { const int j0 = 2 * w, j1 = 2 * w + 1, s0 = (j0 & 3) + 8 * (j0 >> 2) + 4 * hh, s1 = (j1 & 3) + 8 * (j1 >> 2) + 4 * hh;
            const bool k0_ = r < 16 && (dir ? s0 >= r : s0 <= r), k1_ = r < 16 && (dir ? s1 >= r : s1 <= r);
            aw[w] = pk2(k0_ ? X[j0] : 0.f, k1_ ? X[j1] : 0.f); }
        if (!nost) *(GAS v4u*)(F.ws + WS_ATT + idx * 1024 + (size_t)lane * 16) = (v4u){aw[0], aw[1], aw[2], aw[3]};
        asm volatile("" ::: "memory");
    }
}
constexpr int SC_Q = 0, SC_K = 4096, SC_V = 8192, SC_A = 12288, SC_E = 13312, SC_SLOT = 13824, SC_NSLOT = 8, SC_PD = SC_NSLOT - 1  , SC_WGS = 64, SC_NSTEP = 16 + 256;
DI int scan_kb(int j, int b, int dir) { if (j < 16) return 512 + 16 * b + (dir ? 15 - j : j); const int jj = j - 16; return 256 * b + (dir ? 255 - jj : jj); }
DI void scan_issue(const unsigned char* ws, LAS unsigned char* slot, int kb, int head, int dir, int h  , int lane) {
    const size_t kh = (size_t)kb * 16 + head, idx = kh * 2 + dir;
    __builtin_amdgcn_global_load_lds((const unsigned*)(ws + WS_QT + idx * 4096 + (size_t)((lane & 15) * 256 + (4 * h + (lane >> 4)) * 16)), (LAS unsigned*)(slot + SC_Q + h * 1024), 16, 0, 0);
    const size_t ro = (size_t)((64 * (h & 1) + lane) * 32 + (h >> 1) * 16);
    __builtin_amdgcn_global_load_lds((const unsigned*)(ws + WS_KBT + idx * 4096 + ro), (LAS unsigned*)(slot + SC_K + h * 1024), 16, 0, 0);
    __builtin_amdgcn_global_load_lds((const unsigned*)(ws + WS_VT + kh * 4096 + ro), (LAS unsigned*)(slot + SC_V + h * 1024), 16, 0, 0);
    if (h == 1 || h == 2) __builtin_amdgcn_global_load_lds((const unsigned*)(ws + WS_EXPB + idx * 512 + (size_t)(h - 1) * 256 + (size_t)lane * 4), (LAS unsigned*)(slot + SC_E + (h - 1) * 256), 4, 0, 0);
    else __builtin_amdgcn_global_load_lds((const unsigned*)(ws + WS_ATT + idx * 1024 + (size_t)lane * 16), (LAS unsigned*)(slot + SC_A), 16, 0, 0);
}
DI bf16x8 pack_rows(const f32x16& x, int s) {
    v4u p; p.x = pk2(x[8 * s], x[8 * s + 1]); p.y = pk2(x[8 * s + 2], x[8 * s + 3]); p.z = pk2(x[8 * s + 4], x[8 * s + 5]); p.w = pk2(x[8 * s + 6], x[8 * s + 7]);
    return __builtin_bit_cast(bf16x8, p);
}
DI void scan_step(f32x16 (&S)[4], const LAS unsigned char* slot, int vg, float* orow  , int lane) {
    const int r = lane & 31, hh = lane >> 5;
    const LAS unsigned char* qp = slot + SC_Q + (hh * 16 + (r & 15)) * 16;
    const LAS unsigned char* kp = slot + SC_K + (hh * 128 + r) * 16;
    const LAS f32x4* ep = (const LAS f32x4*)(slot + SC_E + hh * 64);
    bf16x8 qf[8], kf[4]; f32x4 e[4][4];
#pragma unroll
    for (int ks = 0; ks < 8; ++ks) qf[ks] = *(const LAS bf16x8*)(qp + ks * 512);
    const bf16x8 af = *(const LAS bf16x8*)(slot + SC_A + lane * 16), vf = *(const LAS bf16x8*)(slot + SC_V + (hh * 128 + 32 * vg + r) * 16);
#pragma unroll
    for (int dt = 0; dt < 4; ++dt) { kf[dt] = *(const LAS bf16x8*)(kp + dt * 512);
#pragma unroll
        for (int g = 0; g < 4; ++g) e[dt][g] = ep[dt * 8 + g]; }
    asm volatile("" ::: "memory");
    f32x16 O;
#pragma unroll
    for (int i = 0; i < 16; ++i) O[i] = 0.f;
#pragma unroll
    for (int dt = 0; dt < 4; ++dt)
#pragma unroll
        for (int s2 = 0; s2 < 2; ++s2) O = MFMA32(qf[2 * dt + s2], pack_rows(S[dt], s2), O);
    O = MFMA32(af, vf, O);
#pragma unroll
    for (int dt = 0; dt < 4; ++dt) {
#pragma unroll
        for (int c = 0; c < 4; ++c) { S[dt][c] *= e[dt][0][c]; S[dt][4 + c] *= e[dt][1][c]; S[dt][8 + c] *= e[dt][2][c]; S[dt][12 + c] *= e[dt][3][c]; }
        S[dt] = MFMA32(kf[dt], vf, S[dt]);
    }
#pragma unroll
    for (int i = 0; i < 8; ++i) { const int t = (i & 3) + 8 * (i >> 2) + 4 * hh; *(GAS float*)(orow + (size_t)t * WA) = O[i]; }
}
#define SC_WAIT(n) asm volatile("s_waitcnt vmcnt(" #n ")" ::: "memory")
#define SC_WAITN(n) asm volatile("s_waitcnt vmcnt(%0)" :: "n"(n) : "memory")
#define SC_BAR() do { asm volatile("" ::: "memory"); __builtin_amdgcn_s_barrier(); asm volatile("" ::: "memory"); } while (0)
DI void scan_wg(Frame& F, int stream) {
    const int lane = F.lane, dir = stream & 1, head = (stream >> 1) & 15, b = stream >> 5;
    LAS unsigned char* ring = F.lds + RING_OFF;
    if (F.wave >= 4) {
        const int h = F.wave - 4;
#pragma unroll
        for (int i = 0; i < SC_PD; ++i) scan_issue(F.ws, ring + i * SC_SLOT, scan_kb(i, b, dir), head, dir, h, lane);
        SC_WAITN(4 * (SC_PD - 1)); SC_BAR();
        for (int j = 0; j < SC_NSTEP; ++j) {
            const int jn = j + SC_PD < SC_NSTEP ? j + SC_PD : SC_NSTEP - 1;
            scan_issue(F.ws, ring + ((j + SC_PD) & (SC_NSLOT - 1)) * SC_SLOT, scan_kb(jn, b, dir), head, dir, h, lane);
            SC_WAITN(4 * (SC_PD - 1)); SC_BAR();
        }
        SC_WAIT(0);
    } else {
        const int vg = F.wave, r = lane & 31;
        float* obase = (float*)(F.ws + (dir ? WS_OB : WS_OF)) + head * DK + 32 * vg + r;
        f32x16 S[4];
#pragma unroll
        for (int dt = 0; dt < 4; ++dt)
#pragma unroll
            for (int i = 0; i < 16; ++i) S[dt][i] = 0.f;
        SC_BAR();
        for (int j = 0; j < SC_NSTEP; ++j) {
            scan_step(S, ring + (j & (SC_NSLOT - 1)) * SC_SLOT, vg, obase + (size_t)(16 * scan_kb(j, b, dir)) * WA, lane);
            SC_BAR();
        }
    }
}
DI void conv_strip(Frame& F, const float* cw  , int task) {
    const bf16* P = (const bf16*)(F.ws + WS_P); bf16* OZ = (bf16*)(F.ws + WS_OAZB);
    const int strip = task >> 2, ch = (task & 3) * 512 + F.lane * 8, row0 = strip * 8;
    const bool hp = row0 < ML ? (row0 & 63) != 0 : ((row0 - ML) & (CTXL - 1)) != 0;
    const bool hn = row0 < ML ? ((row0 + 8) & 63) != 0 : ((row0 + 8 - ML) & (CTXL - 1)) != 0;
    const bf16* pr = P + (size_t)row0 * NIN + ch;
    v4u cg[10], hg[10], bg[8];
#pragma unroll
    for (int j = 0; j < 10; ++j) { const bool ok = j == 0 ? hp : (j == 9 ? hn : true);
        if (ok) { cg[j] = *(const GAS v4u*)(pr + (ptrdiff_t)(j - 1) * NIN + C_CG); hg[j] = *(const GAS v4u*)(pr + (ptrdiff_t)(j - 1) * NIN + C_H); }
        else { cg[j] = (v4u){0u, 0u, 0u, 0u}; hg[j] = cg[j]; } }
#pragma unroll
    for (int i = 0; i < 8; ++i) bg[i] = *(const GAS v4u*)(pr + (size_t)i * NIN + C_BG);
    float w0[8], w1[8], w2[8];
#pragma unroll
    for (int q = 0; q < 2; ++q) { const f32x4 a = *(const f32x4*)(cw + ch + 4 * q), b = *(const f32x4*)(cw + WA + ch + 4 * q), c = *(const f32x4*)(cw + 2 * WA + ch + 4 * q);
#pragma unroll
        for (int k = 0; k < 4; ++k) { w0[4 * q + k] = a[k]; w1[4 * q + k] = b[k]; w2[4 * q + k] = c[k]; } }
    float zm[8], z0[8], zp[8];
#pragma unroll
    for (int w = 0; w < 4; ++w) { zm[2 * w] = bflo(cg[0][w]) * bflo(hg[0][w]); zm[2 * w + 1] = bfhi(cg[0][w]) * bfhi(hg[0][w]); z0[2 * w] = bflo(cg[1][w]) * bflo(hg[1][w]); z0[2 * w + 1] = bfhi(cg[1][w]) * bfhi(hg[1][w]); }
#pragma unroll
    for (int i = 0; i < 8; ++i) {
#pragma unroll
        for (int w = 0; w < 4; ++w) { zp[2 * w] = bflo(cg[i + 2][w]) * bflo(hg[i + 2][w]); zp[2 * w + 1] = bfhi(cg[i + 2][w]) * bfhi(hg[i + 2][w]); }
        unsigned ow[4];
#pragma unroll
        for (int w = 0; w < 4; ++w) {
            const float yl = w0[2 * w] * zm[2 * w] + w1[2 * w] * z0[2 * w] + w2[2 * w] * zp[2 * w], yh = w0[2 * w + 1] * zm[2 * w + 1] + w1[2 * w + 1] * z0[2 * w + 1] + w2[2 * w + 1] * zp[2 * w + 1];
            ow[w] = pk2(bflo(bg[i][w]) * yl, bfhi(bg[i][w]) * yh); }
        *(GAS v4u*)(OZ + (size_t)(row0 + i) * D + WA + ch) = (v4u){ow[0], ow[1], ow[2], ow[3]};
#pragma unroll
        for (int k = 0; k < 8; ++k) { zm[k] = z0[k]; z0[k] = zp[k]; }
    }
}
DI void phase_prep(Frame& F, const float* lbnd, int layer, const float* cw, int flags) {
    const bf16* P = (const bf16*)(F.ws + WS_P);
    const int gw = blockIdx.x * NWAVES + F.wave, NGW = F.G * NWAVES;
    LAS unsigned char* wl = F.lds + RING_OFF + F.wave * 16384;
    for (int tk = gw; tk < NKB * NHEAD; tk += NGW) prep_task(F, P, lbnd, layer, tk >> 4, tk & 15, wl, flags & 1024);
    if (!(flags & 2048)) for (int tk = gw; tk < (MR / 8) * 4; tk += NGW) conv_strip(F, cw, tk);
}
template <class GemmFn>
DI void phase_scan_gemm(Frame& F, int flags, const GemmFn& zb_gemm) {
    const int nsc = F.G >= 2 * SC_WGS ? SC_WGS : 0;
    if (nsc) {
        if ((int)blockIdx.x < nsc) { if (!(flags & 1)) scan_wg(F, (int)blockIdx.x); }
        else if (!(flags & 2)) zb_gemm(F.G - nsc, (int)blockIdx.x - nsc);
    } else {
        if (!(flags & 1)) for (int st = blockIdx.x; st < 64; st += F.G) { scan_wg(F, st); __syncthreads(); }
        if (!(flags & 2)) zb_gemm(F.G, (int)blockIdx.x);
    }
}
DI void phase_combine(Frame& F, const float* gn  , int nrows) {
    const bf16* P = (const bf16*)(F.ws + WS_P); bf16* OZ = (bf16*)(F.ws + WS_OAZB);
    const float* OF = (const float*)(F.ws + WS_OF); const float* OB = (const float*)(F.ws + WS_OB);
    const int gw = blockIdx.x * NWAVES + F.wave, NGW = F.G * NWAVES;
    const int vl = (F.lane & 15) * 8;
    const f32x4 g0 = *(const f32x4*)(gn + vl), g1 = *(const f32x4*)(gn + vl + 4);
    for (int row = gw; row < nrows; row += NGW) {
#pragma unroll
        for (int it = 0; it < 4; ++it) { const int ch = (it * 4 + (F.lane >> 4)) * DK + vl;
            const size_t off = (size_t)row * WA + ch;
            f32x4 a = *(const GAS f32x4*)(OF + off) + *(const GAS f32x4*)(OB + off), b = *(const GAS f32x4*)(OF + off + 4) + *(const GAS f32x4*)(OB + off + 4);
            const v4u gw4 = *(const GAS v4u*)(P + (size_t)row * NIN + C_G + ch);
            float ss = (a[0] * a[0] + a[1] * a[1]) + (a[2] * a[2] + a[3] * a[3]) + (b[0] * b[0] + b[1] * b[1]) + (b[2] * b[2] + b[3] * b[3]);
            ss += shfl_x(ss, 1, F.lane); ss += shfl_x(ss, 2, F.lane); ss += shfl_x(ss, 4, F.lane); ss += shfl_x(ss, 8, F.lane);
            const float rinv = 1.f / sqrtf(ss * (1.f / DK) + RMS_EPS);
            float gl[8];
#pragma unroll
            for (int w = 0; w < 4; ++w) { const float x0 = bflo(gw4[w]), x1 = bfhi(gw4[w]); gl[2 * w] = x0 * sigmoidf_(x0); gl[2 * w + 1] = x1 * sigmoidf_(x1); }
            a = a * rinv * g0; b = b * rinv * g1;
            v4u o; o.x = pk2(a[0] * gl[0], a[1] * gl[1]); o.y = pk2(a[2] * gl[2], a[3] * gl[3]); o.z = pk2(b[0] * gl[4], b[1] * gl[5]); o.w = pk2(b[2] * gl[6], b[3] * gl[7]);
            *(GAS v4u*)(OZ + (size_t)row * D + ch) = o; }
    }
}
constexpr int N_PHASES = 3 + 2 * 10;
struct Args { const float* in[17]; float* out; unsigned char* ws; int ph_lo, ph_hi, flags, pad; };
__global__ void __launch_bounds__(NWAVES * 64, 2) mk_fwd(Args args) {
    extern __shared__ __attribute__((aligned(16))) unsigned char lds[];
    Frame F;
    F.lds = (LAS unsigned char*)lds;
    F.MISC = (volatile LAS unsigned*)(F.lds + MISC_OFF);
    F.tid = threadIdx.x; F.lane = F.tid & 63; F.wave = __builtin_amdgcn_readfirstlane(F.tid >> 6);
    F.G = gridDim.x; F.ws = args.ws;
    F.ctl = (gu32*)(args.ws + WS_CTL);
    for (int u = F.tid; u < (LDS_BYTES - LDSCTL_OFF) / 4; u += NWAVES * 64) ((LAS unsigned*)(F.lds + LDSCTL_OFF))[u] = 0u;
    __syncthreads();
#if MK_SPLIT
#define GRID_BAR() do { } while (0)
#else
    XcdBarrier bar = xcd_barrier_post((unsigned*)(F.ctl + CW_BAR), F.MISC + 8);
#define GRID_BAR() xcd_barrier(bar)
#endif
    unsigned char* ws = args.ws; const CAS Args* ap = nullptr;
#define MODP ((const float*)(ws + WS_MOD))
    const int lo = args.ph_lo, hi = args.ph_hi; (void)lo; (void)hi;
#ifndef PH_MASK
#define PH_MASK 0xffff
#endif
#define EN(kind) (((PH_MASK) >> (kind)) & 1)
#ifndef DUP_MASK
#define DUP_MASK 0
#endif
#define REPS(kind) (1 + (((DUP_MASK) >> (kind)) & 1))
#ifndef RT_RANGE
#define RT_RANGE 0
#define PROBE_LO 0
#define PROBE_HI 0
#define PROBE_FLAGS 0
#endif
#if MK_SPLIT || RT_RANGE
#define IN(k) (lo <= (k) && (k) < hi)
#else
#define IN(k) true
#endif
#define REFRESH() do { int t_; asm volatile("v_mbcnt_lo_u32_b32 %0, -1, 0\n\tv_mbcnt_hi_u32_b32 %0, -1, %0" : "=v"(t_)); t_ += F.wave * 64;     F.tid = t_; F.lane = t_ & 63; ap = (const CAS Args*)__builtin_amdgcn_kernarg_segment_ptr(); asm volatile("" : "+s"(ap)); ws = ap->ws; F.ws = ws; { unsigned lb_ = (unsigned)(size_t)(LAS unsigned char*)lds; asm volatile("" : "+s"(lb_)); F.lds = (LAS unsigned char*)(size_t)lb_; } } while (0)
#define INP(k) (ap->in[k])
#define SEAM(k) do { if (IN(k) && IN((k) + 1)) GRID_BAR(); } while (0)

    for (int rep_ = 0; rep_ < REPS(0); ++rep_) if (EN(0) && IN(0)) { if (rep_) GRID_BAR(); REFRESH(); P0Args A{INP(1), INP(3), INP(4), INP(6), INP(9), INP(10), INP(11), INP(12), INP(13)}; phase0(F, A); } SEAM(0);
    for (int rep_ = 0; rep_ < REPS(1); ++rep_) if (EN(1) && IN(1)) { if (rep_) GRID_BAR(); REFRESH(); phase1(F, INP(5)); } SEAM(1);
#ifdef PROBE_EXTRA_BARRIERS
    for (int xb_ = 0; xb_ < PROBE_EXTRA_BARRIERS; ++xb_) GRID_BAR();
#endif
    for (int rep_ = 0; rep_ < REPS(2); ++rep_) if (EN(2) && IN(2)) { if (rep_) GRID_BAR(); REFRESH(); phase_modulate0(F, INP(0), INP(2)); } SEAM(2);

    for (int l = 0; l < 2; ++l) {
        const int pb = 3 + 10 * l;
        const bool last = (l == 1);
        const int Mrows = last ? ML : MR;
#define MODL (MODP + (size_t)l * 3 * NIN)
        for (int rep_ = 0; rep_ < REPS(3); ++rep_) if (EN(3) && IN(pb + 0)) { if (rep_) GRID_BAR(); REFRESH();
            pg8::Gemm g{(const pg8::bf16_t*)(ws + WS_U), (const pg8::bf16_t*)(ws + WS_WIN + l * SZ_WIN), MR, NIN, D, D}; pg8::StaticOrder S; S.init(MR, NIN, F.G, (int)blockIdx.x);
            pg8::EpiStoreBf16<0> E{(pg8::bf16_t*)(ws + WS_P), NIN, 0};
            pg8::gemm_phase<pg8::EpiStoreBf16<0>, pg8::StaticOrder, true, true>(F.lds + RING_OFF, g, S, E, F.tid);
            if (F.G == 256 && !(ap->flags & 32)) { P0Args A{INP(1), INP(3), INP(4), INP(6), INP(9), INP(10), INP(11), INP(12), INP(13)}; bg_convert(F, A, 192, l == 0 ? BG_S0 : BG_S4, l == 0 ? BG_S1 : BG_S5); }
        } SEAM(pb + 0);
        for (int rep_ = 0; rep_ < REPS(4); ++rep_) if (EN(4) && IN(pb + 1)) { if (rep_) GRID_BAR(); REFRESH(); phase_prep(F, INP(16), l, INP(7) + (size_t)l * 3 * WA, ap->flags); } SEAM(pb + 1);
        for (int rep_ = 0; rep_ < REPS(5); ++rep_) if (EN(5) && IN(pb + 2)) { if (rep_) GRID_BAR(); REFRESH();
            const int fl = ap->flags;
            auto zb_gemm = [&](int G2, int c2) {
                pg8::Gemm g{(const pg8::bf16_t*)(ws + WS_OAZB), (const pg8::bf16_t*)(ws + WS_WAB + l * SZ_WAB), Mrows, D, D, D / 2}; pg8::StaticOrder S; S.init(Mrows, D, G2, c2); S.kc0 = 1;
                pg8::EpiPartB E{(const pg8::bf16_t*)(ws + WS_P), (pg8::bf16_t*)(ws + WS_YPART)};
                pg8::gemm_phase<pg8::EpiPartB, pg8::StaticOrder, true, true>(F.lds + RING_OFF, g, S, E, F.tid); };
            phase_scan_gemm(F, fl, zb_gemm);
        } SEAM(pb + 2);
        for (int rep_ = 0; rep_ < REPS(6); ++rep_) if (EN(6) && IN(pb + 3)) { if (rep_) GRID_BAR(); REFRESH(); phase_combine(F, INP(8) + l * DK, Mrows); } SEAM(pb + 3);
        for (int rep_ = 0; rep_ < REPS(7); ++rep_) if (EN(7) && IN(pb + 4)) { if (rep_) GRID_BAR(); REFRESH();
            pg8::Gemm g{(const pg8::bf16_t*)(ws + WS_OAZB), (const pg8::bf16_t*)(ws + WS_WAB + l * SZ_WAB), Mrows, D, D, D / 2}; pg8::StaticOrder S; S.init(Mrows, D, F.G, (int)blockIdx.x);
            pg8::EpiMergeA E{(const pg8::bf16_t*)(ws + WS_P), (const pg8::bf16_t*)(ws + WS_YPART), (pg8::bf16_t*)(ws + WS_YPRE)};
            pg8::gemm_phase<pg8::EpiMergeA, pg8::StaticOrder, true, true>(F.lds + RING_OFF, g, S, E, F.tid);
            if (F.G == 256 && l == 0 && !(ap->flags & 32)) { P0Args A{INP(1), INP(3), INP(4), INP(6), INP(9), INP(10), INP(11), INP(12), INP(13)}; bg_convert(F, A, 32, BG_S2, BG_S3); }
        } SEAM(pb + 4);
        for (int rep_ = 0; rep_ < REPS(8); ++rep_) if (EN(8) && IN(pb + 5)) { if (rep_) GRID_BAR(); REFRESH();
            { pg8::Gemm g{(const pg8::bf16_t*)(ws + WS_YPRE), (const pg8::bf16_t*)(ws + WS_WO + l * SZ_WO), ML, D, D, D}; pg8::StaticOrder S; S.init(ML, D, F.G, (int)blockIdx.x);
              if (l == 0) { const float* xl = INP(0); pg8::EpiRes E{xl, xl, MODL, 2 * D, (float*)(ws + WS_R), ALPHA};
                  pg8::gemm_phase<pg8::EpiRes, pg8::StaticOrder, true, true>(F.lds + RING_OFF, g, S, E, F.tid); }
              else {
                  pg8::EpiResLn E{(const float*)(ws + WS_ST) + 2 * MR, INP(14) + (size_t)1 * D, INP(15) + (size_t)1 * D, MODL, 2 * D, (float*)(ws + WS_R), ALPHA};
                  pg8::gemm_phase<pg8::EpiResLn, pg8::StaticOrder, true, true>(F.lds + RING_OFF, g, S, E, F.tid); } }
            if (!last) { pg8::Gemm g{(const pg8::bf16_t*)(ws + WS_YPRE) + (size_t)ML * D, (const pg8::bf16_t*)(ws + WS_WO + l * SZ_WO), MC, D, D, D / 8}; pg8::SplitOrder S; S.init(F.G, (int)blockIdx.x);
              pg8::EpiSlab E{(float*)(ws + WS_SLAB), (ap->flags & 512) ? 1 : 0};
              pg8::gemm_phase<pg8::EpiSlab, pg8::SplitOrder, true, true>(F.lds + RING_OFF, g, S, E, F.tid); }
        } SEAM(pb + 5);
        for (int rep_ = 0; rep_ < REPS(9); ++rep_) if (EN(9) && IN(pb + 6)) { if (rep_) GRID_BAR(); REFRESH();
            if (!last) phase_ln<true, true>(F, (const float*)(ws + WS_R), INP(14) + (size_t)(l * 2 + 0) * D, INP(15) + (size_t)(l * 2 + 0) * D, (float*)(ws + WS_X1), ML  , (float*)(ws + WS_ST), MR, MODL, 3 * D, 4 * D, (const float*)(ws + WS_SLAB), INP(2), MODL + 2 * NIN + 2 * D);
            else phase_ln<true, false>(F, (const float*)(ws + WS_R), INP(14) + (size_t)(l * 2 + 0) * D, INP(15) + (size_t)(l * 2 + 0) * D, (float*)(ws + WS_X1), 0x7fffffff, (float*)(ws + WS_ST), ML, MODL, 3 * D, 4 * D, nullptr, nullptr, nullptr);
        } SEAM(pb + 6);
        for (int rep_ = 0; rep_ < REPS(10); ++rep_) if (EN(10) && IN(pb + 7)) { if (rep_) GRID_BAR(); REFRESH();
            pg8::Gemm g{(const pg8::bf16_t*)(ws + WS_U), (const pg8::bf16_t*)(ws + WS_WUP + l * SZ_WUP), Mrows, DFF, D, (ap->flags & 16) ? D / 4 : D}; pg8::StaticOrder S; S.init(Mrows, DFF, F.G, (int)blockIdx.x); if (ap->flags & 4) S.bmask = 0; if (ap->flags & 8) S.amask = 0;
            if (ap->flags & 128) { S.init(Mrows, DFF, F.G / 2, (int)blockIdx.x >> 1); if (blockIdx.x & 1) S.nwg = 0; }
            pg8::EpiStoreBf16<1> E{(pg8::bf16_t*)(ws + WS_H), DFF, (ap->flags & 64) ? 1 : 0};
            pg8::gemm_phase<pg8::EpiStoreBf16<1>, pg8::StaticOrder, true, true>(F.lds + RING_OFF, g, S, E, F.tid);
            if (F.G == 256 && l == 0 && !(ap->flags & 32)) { P0Args A{INP(1), INP(3), INP(4), INP(6), INP(9), INP(10), INP(11), INP(12), INP(13)}; bg_convert(F, A, 128, BG_S3, BG_S4); }
        } SEAM(pb + 7);
        for (int rep_ = 0; rep_ < REPS(11); ++rep_) if (EN(11) && IN(pb + 8)) { if (rep_) GRID_BAR(); REFRESH();
            { pg8::Gemm g{(const pg8::bf16_t*)(ws + WS_H), (const pg8::bf16_t*)(ws + WS_WDN + l * SZ_WDN), ML, D, DFF, DFF}; pg8::StaticOrder S; S.init(ML, D, F.G, (int)blockIdx.x);
              pg8::EpiResLn E{(const float*)(ws + WS_ST), INP(14) + (size_t)(l * 2 + 0) * D, INP(15) + (size_t)(l * 2 + 0) * D, MODL, 5 * D, (float*)(ws + WS_R), ALPHA};
              pg8::gemm_phase<pg8::EpiResLn, pg8::StaticOrder, true, true>(F.lds + RING_OFF, g, S, E, F.tid); }
            if (!last && !(ap->flags & 256)) { pg8::Gemm g{(const pg8::bf16_t*)(ws + WS_H) + (size_t)ML * DFF, (const pg8::bf16_t*)(ws + WS_WDN + l * SZ_WDN), MC, D, DFF, DFF / 8}; pg8::SplitOrder S; S.init(F.G, (int)blockIdx.x);
              pg8::EpiSlab E{(float*)(ws + WS_SLAB), (ap->flags & 512) ? 1 : 0};
              pg8::gemm_phase<pg8::EpiSlab, pg8::SplitOrder, true, true>(F.lds + RING_OFF, g, S, E, F.tid); }
        } SEAM(pb + 8);
        for (int rep_ = 0; rep_ < REPS(12); ++rep_) if (EN(12) && IN(pb + 9)) { if (rep_) GRID_BAR(); REFRESH();
            if (!last) phase_ln<true, true>(F, (const float*)(ws + WS_R), INP(14) + (size_t)(l * 2 + 1) * D, INP(15) + (size_t)(l * 2 + 1) * D, (float*)(ws + WS_X2), 0x7fffffff  , (float*)(ws + WS_ST) + 2 * MR, MR, MODP + (size_t)(l + 1) * 3 * NIN, 0, D, (const float*)(ws + WS_SLAB), (const float*)(ws + WS_X1) + (size_t)ML * D, MODL + 2 * NIN + 5 * D);
            else phase_ln<false, false>(F, (const float*)(ws + WS_R), INP(14) + (size_t)(l * 2 + 1) * D, INP(15) + (size_t)(l * 2 + 1) * D, ap->out, 0, nullptr, ML, nullptr, 0, 0, nullptr, nullptr, nullptr);
        }
        if (!last) SEAM(pb + 9);
    }
#undef IN
#undef SEAM
}

extern "C" void kernel_launch(void* const* d_in, const int* in_sizes, int n_in, void* d_out, int out_size, void* d_ws, size_t ws_size, hipStream_t stream) {
    static int grid = 0;
    if (grid == 0) {
        if (n_in != 17 || in_sizes[0] != ML * D || out_size != ML * D || ws_size < WS_END) {
            fprintf(stderr, "kernel_launch: unexpected shapes (n_in %d, in0 %d, out %d, ws %zu < %zu); nothing launched\n", n_in, n_in > 0 ? in_sizes[0] : -1, out_size, ws_size, (size_t)WS_END); grid = -1; return; }
        int dev = 0, cus = 0, per_cu = 0;
        if (hipGetDevice(&dev) != hipSuccess || hipDeviceGetAttribute(&cus, hipDeviceAttributeMultiprocessorCount, dev) != hipSuccess) { fprintf(stderr, "kernel_launch: device query failed\n"); grid = -1; return; }
        if (hipFuncSetAttribute((const void*)mk_fwd, hipFuncAttributeMaxDynamicSharedMemorySize, LDS_BYTES) != hipSuccess) { fprintf(stderr, "kernel_launch: hipFuncSetAttribute failed\n"); grid = -1; return; }
        if (hipOccupancyMaxActiveBlocksPerMultiprocessor(&per_cu, (const void*)mk_fwd, NWAVES * 64, LDS_BYTES) != hipSuccess || per_cu < 1)
            fprintf(stderr, "kernel_launch: note: occupancy query reports %d workgroups per CU\n", per_cu);
        (void)hipGetLastError();
        grid = cus;
    }
    if (grid < 0) return;
    if (hipMemsetAsync((char*)d_ws + WS_CTL, 0, CTL_ZERO_BYTES, stream) != hipSuccess) { fprintf(stderr, "kernel_launch: memset failed\n"); return; }
    Args a{};
    for (int i = 0; i < 17; ++i) a.in[i] = (const float*)d_in[i];
    a.out = (float*)d_out; a.ws = (unsigned char*)d_ws;
#if MK_SPLIT
    for (int ph = 0; ph < N_PHASES; ++ph) { a.ph_lo = ph; a.ph_hi = ph + 1; hipLaunchKernelGGL(mk_fwd, dim3(grid), dim3(NWAVES * 64), LDS_BYTES, stream, a); }
#else
    a.ph_lo = 0; a.ph_hi = N_PHASES;
    hipLaunchKernelGGL(mk_fwd, dim3(grid), dim3(NWAVES * 64), LDS_BYTES, stream, a);
#if RT_RANGE
    for (int l = 0; l < 2; ++l) { (void)hipMemsetAsync((char*)d_ws + WS_CTL, 0, CTL_ZERO_BYTES, stream); a.ph_lo = 3 + 10 * l + PROBE_LO; a.ph_hi = 3 + 10 * l + PROBE_HI; a.flags = PROBE_FLAGS; hipLaunchKernelGGL(mk_fwd, dim3(grid), dim3(NWAVES * 64), LDS_BYTES, stream, a); }
#endif
#endif
    const hipError_t le = hipPeekAtLastError();
    if (le != hipSuccess) fprintf(stderr, "kernel_launch: launch failed: %s\n", hipGetErrorName(le));
}
```

```cpp
#include <hip/hip_runtime.h>
#include <cstdio>
#include <cstdint>

#ifndef MK_SPLIT
#define MK_SPLIT 0
#endif

namespace pg8 {
#define PG8_LAS __attribute__((address_space(3)))
typedef unsigned short bf16_t;
typedef short bf16x8 __attribute__((ext_vector_type(8)));
typedef float f32x4 __attribute__((ext_vector_type(4)));
typedef unsigned u32x4 __attribute__((ext_vector_type(4)));
constexpr int BM = 256, BK = 64, HALF = 128, HTB = HALF * BK * 2  , STAGE_BYTES = 8 * HTB, NXCD = 8, WGM = 8;

__host__ __device__ __forceinline__ int lds_byte(int r, int c) { const int st = (r >> 4) * 2 + (c >> 5), rr = r & 15, cc = c & 31, ob = rr * 64 + cc * 2; return st * 1024 + (ob ^ (((ob >> 9) & 1) << 5)); }
__host__ __device__ __forceinline__ void stage_rc(int b, int& R, int& C) { const int st = b / 1024, sb = b % 1024, swz = sb ^ (((sb >> 9) & 1) << 5); R = (st >> 1) * 16 + swz / 64; C = (st & 1) * 32 + (swz % 64) / 2; }
__host__ __device__ __forceinline__ int perm32(int rho) { const int n = rho >> 4, i = rho & 15; return 8 * (i >> 2) + 4 * n + (i & 3); }

struct Unit { int pm, pn, kc, am, bn; };
struct Gemm { const bf16_t* A; const bf16_t* Bt; int M, N, K, Kc; };

struct StaticOrder {
    int nM, nN, nwg, G, c, amask = -1, bmask = -1, kc0 = 0;
    __host__ __device__ void init(int M, int N, int G_, int c_) { nM = M / BM; nN = N / BM; nwg = nM * nN; G = G_; c = c_; }
    __host__ __device__ bool next(int i, Unit& u) const {
        const long L = (long)i * G + c; if (L >= nwg) return false;
        int wgid = (int)L; { const int q = nwg / NXCD, r = nwg % NXCD, xcd = wgid % NXCD, off = wgid / NXCD; wgid = (xcd < r ? xcd * (q + 1) : r * (q + 1) + (xcd - r) * q) + off; }
        const int nig = WGM * nN, gid = wgid / nig, fm = gid * WGM, gsz = (nM - fm) < WGM ? (nM - fm) : WGM;
        u.pm = fm + ((wgid % nig) % gsz); u.pn = (wgid % nig) / gsz; u.kc = kc0; u.am = u.pm & amask; u.bn = u.pn & bmask; return true;
    }
    __device__ __forceinline__ void a_ready(const Unit&) const {}
    __device__ __forceinline__ void done(const Unit&) const {}
};

__device__ __forceinline__ unsigned cvt_pk_bf16(float lo, float hi) { unsigned r; asm volatile("v_cvt_pk_bf16_f32 %0, %1, %2" : "=v"(r) : "v"(lo), "v"(hi)); return r; }
__device__ __forceinline__ float bf_lo(unsigned w) { return __uint_as_float(w << 16); }
__device__ __forceinline__ float bf_hi(unsigned w) { return __uint_as_float(w & 0xffff0000u); }

struct SplitOrder {
    int G, c;
    __host__ __device__ void init(int G_, int c_) { G = G_; c = c_; }
    __host__ __device__ bool next(int i, Unit& u) const { const int L = i * G + c; if (L >= 256) return false; u.kc = L & 7; const int t = L >> 3; u.pm = t & 1; u.pn = t >> 1; u.am = u.pm; u.bn = u.pn; return true; }
    __device__ __forceinline__ void a_ready(const Unit&) const {}
    __device__ __forceinline__ void done(const Unit&) const {}
};

template <int ACT  > struct EpiStoreBf16 {
    static constexpr bool PERM = true, AFTER_DRAIN = false, HAS_MID = false;
    bf16_t* O; int ldc; int skip;
    __device__ __forceinline__ void mid(f32x4 (&)[2][2][4][2], const Unit&, int, int, int, int) const {}
    __device__ __forceinline__ void operator()(f32x4 (&acc)[2][2][4][2], const Unit& u, int wr, int wc, int fr, int fq) const {
        if (skip) return;
        const int row0 = u.pm * BM + wr * 64 + fr, col0 = u.pn * BM + wc * 32 + 8 * fq;
#pragma unroll
        for (int ai = 0; ai < 2; ++ai)
#pragma unroll
            for (int m = 0; m < 4; ++m) { bf16_t* rowp = O + (size_t)(row0 + ai * HALF + m * 16) * ldc + col0;
#pragma unroll
                for (int bj = 0; bj < 2; ++bj) { f32x4 v0 = acc[ai][bj][m][0], v1 = acc[ai][bj][m][1];
                    if (ACT == 1) {
#pragma unroll
                        for (int j = 0; j < 4; ++j) { const float a = fmaxf(v0[j], 0.f), b = fmaxf(v1[j], 0.f); v0[j] = a * a; v1[j] = b * b; } }
                    u32x4 w; w.x = cvt_pk_bf16(v0[0], v0[1]); w.y = cvt_pk_bf16(v0[2], v0[3]); w.z = cvt_pk_bf16(v1[0], v1[1]); w.w = cvt_pk_bf16(v1[2], v1[3]);
                    *(u32x4*)(rowp + bj * HALF) = w; } }
    }
};
struct EpiRes {
    static constexpr bool PERM = false, AFTER_DRAIN = false, HAS_MID = false;
    const float* xlat; const float* xctx; const float* modl; int which; float* R; float alpha;
    __device__ __forceinline__ void mid(f32x4 (&)[2][2][4][2], const Unit&, int, int, int, int) const {}
    __device__ __forceinline__ void operator()(f32x4 (&acc)[2][2][4][2], const Unit& u, int wr, int wc, int fr, int fq) const {
        const int rl0 = wr * 64 + fr, col0 = u.pn * BM + wc * 32 + 4 * fq;
        const int vec = u.pm < 16 ? 0 : (u.pm < 32 ? 1 : 2);
        const float* g = modl + vec * 24576 + which + col0;
        const float* xb = (u.pm < 32 ? xlat + (size_t)u.pm * BM * 4096 : xctx + (size_t)(u.pm - 32) * BM * 4096) + col0;
        float* rb = R + (size_t)u.pm * BM * 4096 + col0;
        f32x4 gv[2][2];
#pragma unroll
        for (int bj = 0; bj < 2; ++bj)
#pragma unroll
            for (int n = 0; n < 2; ++n) gv[bj][n] = *(const f32x4*)(g + bj * HALF + n * 16);
#pragma unroll
        for (int ai = 0; ai < 2; ++ai)
#pragma unroll
            for (int m = 0; m < 4; ++m) { const size_t ro = (size_t)(rl0 + ai * HALF + m * 16) * 4096;
#pragma unroll
                for (int bj = 0; bj < 2; ++bj)
#pragma unroll
                    for (int n = 0; n < 2; ++n) { const f32x4 xs = *(const f32x4*)(xb + ro + bj * HALF + n * 16);
                        *(f32x4*)(rb + ro + bj * HALF + n * 16) = xs * alpha + gv[bj][n] * acc[ai][bj][m][n]; }
                asm volatile("" ::: "memory"); }
    }
};
struct EpiResLn {
    static constexpr bool PERM = false, AFTER_DRAIN = false, HAS_MID = false;
    const float* st; const float* lng; const float* lnb; const float* modl; int which; float* R; float alpha;
    __device__ __forceinline__ void mid(f32x4 (&)[2][2][4][2], const Unit&, int, int, int, int) const {}
    __device__ __forceinline__ void operator()(f32x4 (&acc)[2][2][4][2], const Unit& u, int wr, int wc, int fr, int fq) const {
        const int rl0 = wr * 64 + fr, col0 = u.pn * BM + wc * 32 + 4 * fq;
        const int vec = u.pm < 16 ? 0 : 1;
        const float* g = modl + vec * 24576 + which + col0;
        float* rb = R + (size_t)u.pm * BM * 4096 + col0;
        f32x4 gv[2][2];
        const float* sp = st + (size_t)(u.pm * BM + rl0) * 2;
#pragma unroll
        for (int bj = 0; bj < 2; ++bj)
#pragma unroll
            for (int n = 0; n < 2; ++n) gv[bj][n] = *(const f32x4*)(g + bj * HALF + n * 16);
#pragma unroll
        for (int ai = 0; ai < 2; ++ai)
#pragma unroll
            for (int m = 0; m < 4; ++m) { const size_t ro = (size_t)(rl0 + ai * HALF + m * 16) * 4096;
                const float mean = sp[(ai * HALF + m * 16) * 2], rs = sp[(ai * HALF + m * 16) * 2 + 1] * alpha;
                int c = col0; asm volatile("" : "+v"(c));
#pragma unroll
                for (int bj = 0; bj < 2; ++bj)
#pragma unroll
                    for (int n = 0; n < 2; ++n) { const f32x4 ro_ = *(const f32x4*)(rb + ro + bj * HALF + n * 16);
                        const f32x4 la = *(const f32x4*)(lng + c + bj * HALF + n * 16), lb = *(const f32x4*)(lnb + c + bj * HALF + n * 16);
                        *(f32x4*)(rb + ro + bj * HALF + n * 16) = (ro_ - mean) * rs * la + lb * alpha + gv[bj][n] * acc[ai][bj][m][n]; }
                asm volatile("" ::: "memory"); }
    }
};
struct EpiSlab {
    static constexpr bool PERM = false, AFTER_DRAIN = false, HAS_MID = false;
    float* slab; int skip;
    __device__ __forceinline__ void mid(f32x4 (&)[2][2][4][2], const Unit&, int, int, int, int) const {}
    __device__ __forceinline__ void operator()(f32x4 (&acc)[2][2][4][2], const Unit& u, int wr, int wc, int fr, int fq) const {
        if (skip) return;
        float* rb = slab + ((size_t)u.kc * 512 + (size_t)u.pm * BM + wr * 64 + fr) * 4096 + u.pn * BM + wc * 32 + 4 * fq;
#pragma unroll
        for (int ai = 0; ai < 2; ++ai)
#pragma unroll
            for (int m = 0; m < 4; ++m)
#pragma unroll
                for (int bj = 0; bj < 2; ++bj)
#pragma unroll
                    for (int n = 0; n < 2; ++n) *(f32x4*)(rb + (size_t)(ai * HALF + m * 16) * 4096 + bj * HALF + n * 16) = acc[ai][bj][m][n];
    }
};
struct EpiPartB {
    static constexpr bool PERM = true, AFTER_DRAIN = false, HAS_MID = false;
    const bf16_t* P; bf16_t* YP;
    __device__ __forceinline__ void mid(f32x4 (&)[2][2][4][2], const Unit&, int, int, int, int) const {}
    __device__ __forceinline__ void operator()(f32x4 (&acc)[2][2][4][2], const Unit& u, int wr, int wc, int fr, int fq) const {
        const int row0 = u.pm * BM + wr * 64 + fr, col0 = u.pn * BM + wc * 32 + 8 * fq;
#pragma unroll
        for (int ai = 0; ai < 2; ++ai)
#pragma unroll
            for (int m = 0; m < 4; ++m) { const size_t row = (size_t)(row0 + ai * HALF + m * 16);
#pragma unroll
                for (int bj = 0; bj < 2; ++bj) { const u32x4 gb = *(const u32x4*)(P + row * 24576 + 20480 + col0 + bj * HALF);
                    float o[8];
#pragma unroll
                    for (int w = 0; w < 4; ++w) {
                        const float s0 = __builtin_amdgcn_rcpf(1.f + __builtin_amdgcn_exp2f(-1.44269504f * bf_lo(gb[w]))), s1 = __builtin_amdgcn_rcpf(1.f + __builtin_amdgcn_exp2f(-1.44269504f * bf_hi(gb[w])));
                        o[2 * w] = acc[ai][bj][m][w >> 1][(w & 1) * 2] * s0; o[2 * w + 1] = acc[ai][bj][m][w >> 1][(w & 1) * 2 + 1] * s1; }
                    u32x4 wv; wv.x = cvt_pk_bf16(o[0], o[1]); wv.y = cvt_pk_bf16(o[2], o[3]); wv.z = cvt_pk_bf16(o[4], o[5]); wv.w = cvt_pk_bf16(o[6], o[7]);
                    *(u32x4*)(YP + row * 4096 + col0 + bj * HALF) = wv; }
                asm volatile("" ::: "memory"); }
    }
};
struct EpiMergeA {
    static constexpr bool PERM = true, AFTER_DRAIN = false, HAS_MID = false;
    const bf16_t* P; const bf16_t* YP; bf16_t* Y;
    __device__ __forceinline__ void mid(f32x4 (&)[2][2][4][2], const Unit&, int, int, int, int) const {}
    __device__ __forceinline__ void operator()(f32x4 (&acc)[2][2][4][2], const Unit& u, int wr, int wc, int fr, int fq) const {
        const int row0 = u.pm * BM + wr * 64 + fr, col0 = u.pn * BM + wc * 32 + 8 * fq;
#pragma unroll
        for (int ai = 0; ai < 2; ++ai)
#pragma unroll
            for (int m = 0; m < 4; ++m) { const size_t row = (size_t)(row0 + ai * HALF + m * 16);
#pragma unroll
                for (int bj = 0; bj < 2; ++bj) { const u32x4 ga = *(const u32x4*)(P + row * 24576 + 16384 + col0 + bj * HALF), yp = *(const u32x4*)(YP + row * 4096 + col0 + bj * HALF);
                    float o[8];
#pragma unroll
                    for (int w = 0; w < 4; ++w) {
                        const float s0 = __builtin_amdgcn_rcpf(1.f + __builtin_amdgcn_exp2f(-1.44269504f * bf_lo(ga[w]))), s1 = __builtin_amdgcn_rcpf(1.f + __builtin_amdgcn_exp2f(-1.44269504f * bf_hi(ga[w])));
                        o[2 * w] = acc[ai][bj][m][w >> 1][(w & 1) * 2] * s0 + bf_lo(yp[w]); o[2 * w + 1] = acc[ai][bj][m][w >> 1][(w & 1) * 2 + 1] * s1 + bf_hi(yp[w]); }
                    u32x4 wv; wv.x = cvt_pk_bf16(o[0], o[1]); wv.y = cvt_pk_bf16(o[2], o[3]); wv.z = cvt_pk_bf16(o[4], o[5]); wv.w = cvt_pk_bf16(o[6], o[7]);
                    *(u32x4*)(Y + row * 4096 + col0 + bj * HALF) = wv; }
                asm volatile("" ::: "memory"); }
    }
};

template <class Epi, class Sched, bool ALIGN_EPI = false, bool SP2 = false>
__device__ __forceinline__ void gemm_phase(PG8_LAS unsigned char* lds, const Gemm g, const Sched& S, const Epi& E, const int tid) {
    const int wid = __builtin_amdgcn_readfirstlane(tid >> 6), lane = tid & 63, wr = wid >> 2, wc = wid & 3, fr = lane & 15, fq = lane >> 4;
    const int K = g.K, nt = g.Kc / BK;
    unsigned voffA[2], voffB[2];
#pragma unroll
    for (int i = 0; i < 2; ++i) { int R, C; stage_rc(tid * 16 + i * 8192, R, C); const int Rb = Epi::PERM ? ((R & ~31) + perm32(R & 31)) : R;
        voffA[i] = (unsigned)(R * K + C) * 2u; voffB[i] = (unsigned)(Rb * BK + C) * 2u; }
    const size_t kstep = (size_t)(BK * 2);
    const size_t hstep = (size_t)HALF * K * 2;
    const size_t tstep = 2 * hstep;
    const size_t kstepB = (size_t)BM * BK * 2, hstepB = (size_t)HALF * BK * 2;
    const unsigned ldsw = (unsigned)wid * 1024u;
    const int aoff = lds_byte(wr * 64 + fr, fq * 8), boff = lds_byte(wc * 32 + fr, fq * 8);
#define PG8_SA(b, h) (((b) * 2 + (h)) * HTB)
#define PG8_SB(b, h) ((4 + (b) * 2 + (h)) * HTB)
#define PG8_STAGE(bufoff, gbase, voff) do { _Pragma("unroll") for (int _i = 0; _i < 2; ++_i) \
        __builtin_amdgcn_global_load_lds((const unsigned*)((const char*)(gbase) + (voff)[_i]), (PG8_LAS unsigned*)(lds + (bufoff) + ldsw + _i * 8192), 16, 0, 0); } while (0)
#define PG8_LDA(dst, b, h) do { _Pragma("unroll") for (int m = 0; m < 4; ++m) _Pragma("unroll") for (int k = 0; k < 2; ++k) dst[m][k] = *(const PG8_LAS bf16x8*)(lds + PG8_SA(b, h) + aoff + m * 2048 + k * 1024); } while (0)
#define PG8_LDB(dst, b, h) do { _Pragma("unroll") for (int n = 0; n < 2; ++n) _Pragma("unroll") for (int k = 0; k < 2; ++k) dst[n][k] = *(const PG8_LAS bf16x8*)(lds + PG8_SB(b, h) + boff + n * 2048 + k * 1024); } while (0)
#define PG8_MMA(ai, bj, At, Bt) do { __builtin_amdgcn_s_setprio(1); _Pragma("unroll") for (int m = 0; m < 4; ++m) _Pragma("unroll") for (int n = 0; n < 2; ++n) _Pragma("unroll") for (int k = 0; k < 2; ++k) \
        acc[ai][bj][m][n] = __builtin_amdgcn_mfma_f32_16x16x32_bf16(Bt[n][k], At[m][k], acc[ai][bj][m][n], 0, 0, 0); __builtin_amdgcn_s_setprio(0); } while (0)
#define PG8_WAIT_V(n) asm volatile("s_waitcnt vmcnt(" #n ")" ::: "memory")
#define PG8_WAIT_L(n) asm volatile("s_waitcnt lgkmcnt(" #n ")" ::: "memory")
#define PG8_BAR __builtin_amdgcn_s_barrier()
#define PG8_SCHED __builtin_amdgcn_sched_barrier(0)
    Unit cur, nxt; int ui = 0;
    if (!S.next(0, cur)) return;
    f32x4 acc[2][2][4][2];
#pragma unroll
    for (int a = 0; a < 2; ++a)
#pragma unroll
        for (int b = 0; b < 2; ++b)
#pragma unroll
            for (int m = 0; m < 4; ++m)
#pragma unroll
                for (int n = 0; n < 2; ++n) acc[a][b][m][n] = (f32x4){0.f, 0.f, 0.f, 0.f};
    bf16x8 At[4][2], B0[2][2], B1[2][2];
    const size_t cstep = (size_t)g.Kc * 2, cstepB = (size_t)(g.Kc / BK) * kstepB;
    const char* cA = (const char*)g.A + (size_t)cur.am * tstep + (size_t)cur.kc * cstep; const char* cB = (const char*)g.Bt + (size_t)cur.bn * tstep + (size_t)cur.kc * cstepB;
    S.a_ready(cur);
    if constexpr (SP2) {
        PG8_STAGE(PG8_SB(0, 0), cB, voffB); PG8_STAGE(PG8_SB(0, 1), cB + hstepB, voffB); PG8_STAGE(PG8_SA(0, 0), cA, voffA); PG8_STAGE(PG8_SA(0, 1), cA + hstep, voffA);
        if (wr == 1) PG8_BAR;
        PG8_WAIT_V(2); PG8_BAR;
        PG8_STAGE(PG8_SB(1, 0), cB + kstepB, voffB); PG8_STAGE(PG8_SA(1, 0), cA + kstep, voffA); PG8_STAGE(PG8_SB(1, 1), cB + hstepB + kstepB, voffB);
        PG8_WAIT_V(6); PG8_BAR;
    } else {
        PG8_STAGE(PG8_SB(0, 0), cB, voffB); PG8_STAGE(PG8_SA(0, 0), cA, voffA); PG8_STAGE(PG8_SB(0, 1), cB + hstepB, voffB); PG8_STAGE(PG8_SA(0, 1), cA + hstep, voffA);
        if (wr == 1) PG8_BAR;
        PG8_WAIT_V(4); PG8_BAR;
        PG8_STAGE(PG8_SB(1, 0), cB + kstepB, voffB); PG8_STAGE(PG8_SA(1, 0), cA + kstep, voffA); PG8_STAGE(PG8_SB(1, 1), cB + hstepB + kstepB, voffB);
        PG8_WAIT_V(6); PG8_BAR;
    }
    for (;;) {
        const bool has_next = S.next(ui + 1, nxt);
        const char* nA = has_next ? (const char*)g.A + (size_t)nxt.am * tstep + (size_t)nxt.kc * cstep : cA; const char* nB = has_next ? (const char*)g.Bt + (size_t)nxt.bn * tstep + (size_t)nxt.kc * cstepB : cB;
        for (int t = 0; t < nt; t += 2) {
            const bool last = (t == nt - 2);
            const char* a1 = cA + (size_t)(t + 1) * kstep;
            const char* a2 = last ? nA : cA + (size_t)(t + 2) * kstep; const char* b2 = last ? nB : cB + (size_t)(t + 2) * kstepB;
            const char* a3 = a2 + kstep; const char* b3 = b2 + kstepB;
            if (last && has_next) S.a_ready(nxt);
            if constexpr (Epi::HAS_MID) { if (t == (nt >> 1)) E.mid(acc, cur, wr, wc, fr, fq); }
            if constexpr (SP2) {
            PG8_LDB(B0, 0, 0); PG8_LDB(B1, 0, 1); PG8_SCHED; PG8_LDA(At, 0, 0); PG8_STAGE(PG8_SA(1, 1), a1 + hstep, voffA);
            PG8_WAIT_V(8); PG8_WAIT_L(0); PG8_BAR; PG8_MMA(0, 0, At, B0); PG8_MMA(0, 1, At, B1); PG8_BAR; PG8_SCHED;
            PG8_LDA(At, 0, 1); PG8_STAGE(PG8_SB(0, 0), b2, voffB); PG8_STAGE(PG8_SB(0, 1), b2 + hstepB, voffB); PG8_STAGE(PG8_SA(0, 0), a2, voffA);
            PG8_WAIT_V(8); PG8_WAIT_L(0); PG8_BAR; PG8_MMA(1, 0, At, B0); PG8_MMA(1, 1, At, B1); PG8_BAR; PG8_SCHED;
            PG8_LDB(B0, 1, 0); PG8_LDB(B1, 1, 1); PG8_SCHED; PG8_LDA(At, 1, 0); PG8_STAGE(PG8_SA(0, 1), a2 + hstep, voffA);
            PG8_WAIT_V(8); PG8_WAIT_L(0); PG8_BAR; PG8_MMA(0, 0, At, B0); PG8_MMA(0, 1, At, B1); PG8_BAR; PG8_SCHED;
            PG8_LDA(At, 1, 1); PG8_STAGE(PG8_SB(1, 0), b3, voffB); PG8_STAGE(PG8_SB(1, 1), b3 + hstepB, voffB); PG8_STAGE(PG8_SA(1, 0), a3, voffA);
            PG8_WAIT_V(8); PG8_WAIT_L(0); PG8_BAR; PG8_MMA(1, 0, At, B0); PG8_MMA(1, 1, At, B1); PG8_BAR; PG8_SCHED;
            } else {
            PG8_LDB(B0, 0, 0); PG8_SCHED; PG8_LDA(At, 0, 0); PG8_STAGE(PG8_SA(1, 1), a1 + hstep, voffA);
            PG8_WAIT_L(8); PG8_BAR; PG8_WAIT_L(0); PG8_MMA(0, 0, At, B0); PG8_BAR; PG8_SCHED;
            PG8_LDB(B1, 0, 1); PG8_STAGE(PG8_SB(0, 0), b2, voffB);
            PG8_BAR; PG8_WAIT_L(0); PG8_MMA(0, 1, At, B1); PG8_BAR;
            PG8_LDA(At, 0, 1); PG8_STAGE(PG8_SA(0, 0), a2, voffA);
            PG8_BAR; PG8_WAIT_L(0); PG8_MMA(1, 0, At, B0); PG8_BAR; PG8_SCHED;
            PG8_STAGE(PG8_SB(0, 1), b2 + hstepB, voffB);
            PG8_WAIT_V(6); PG8_BAR; PG8_MMA(1, 1, At, B1); PG8_BAR;
            PG8_LDB(B0, 1, 0); PG8_SCHED; PG8_LDA(At, 1, 0); PG8_STAGE(PG8_SA(0, 1), a2 + hstep, voffA);
            PG8_WAIT_L(8); PG8_BAR; PG8_WAIT_L(0); PG8_MMA(0, 0, At, B0); PG8_BAR; PG8_SCHED;
            PG8_LDB(B1, 1, 1); PG8_STAGE(PG8_SB(1, 0), b3, voffB);
            PG8_BAR; PG8_WAIT_L(0); PG8_MMA(0, 1, At, B1); PG8_BAR;
            PG8_LDA(At, 1, 1); PG8_STAGE(PG8_SA(1, 0), a3, voffA);
            PG8_BAR; PG8_WAIT_L(0); PG8_MMA(1, 0, At, B0); PG8_BAR; PG8_SCHED;
            PG8_STAGE(PG8_SB(1, 1), b3 + hstepB, voffB);
            PG8_WAIT_V(6); PG8_BAR; PG8_MMA(1, 1, At, B1); PG8_BAR;
            }
        }
        if constexpr (ALIGN_EPI) { if (wr == 0) PG8_BAR; }
        if constexpr (!Epi::AFTER_DRAIN) { E(acc, cur, wr, wc, fr, fq); S.done(cur); }
        if (!has_next) break;
#pragma unroll
        for (int a = 0; a < 2; ++a)
#pragma unroll
            for (int b = 0; b < 2; ++b)
#pragma unroll
                for (int m = 0; m < 4; ++m)
#pragma unroll
                    for (int n = 0; n < 2; ++n) acc[a][b][m][n] = (f32x4){0.f, 0.f, 0.f, 0.f};
        cur = nxt; cA = nA; cB = nB; ++ui;
        if constexpr (ALIGN_EPI) { if (wr == 1) PG8_BAR; }
    }
    PG8_WAIT_V(0);
    if constexpr (!ALIGN_EPI) { if (wr == 0) PG8_BAR; }
    PG8_BAR;
    if constexpr (Epi::AFTER_DRAIN) { E.fused(acc, cur, wr, wc, fr, fq, lds, wid, lane); S.done(cur); }
#undef PG8_SA
#undef PG8_SB
#undef PG8_STAGE
#undef PG8_LDA
#undef PG8_LDB
#undef PG8_MMA
#undef PG8_WAIT_V
#undef PG8_WAIT_L
#undef PG8_BAR
#undef PG8_SCHED
}
}

constexpr int NWAVES = 8;
constexpr int D = 4096, NBATCH = 2, SEQ = 4096, CTXL = 256, ML = NBATCH * SEQ  , MC = NBATCH * CTXL  , MR = ML + MC  ;
constexpr int NIN = 24576, DFF = 16384, WA = 2048, NHEAD = 16, DK = 128, NMOD = 6 * D, NKB = MR / 16  ;
constexpr int C_FF = 0, C_FB = 2048, C_I = 4096, C_Q = 6144, C_G = 8192, C_BG = 10240, C_CG = 12288, C_H = 14336, C_GA = 16384, C_GB = 20480;
constexpr float LN_EPS = 1e-5f, RMS_EPS = 1e-6f;
constexpr float ALPHA = 1.41421356237309515f;
constexpr int KSPLIT = 32;

constexpr size_t MiB = 1u << 20;
constexpr size_t WS_CTL = 0, CTL_ZERO_BYTES = 1 * MiB;
constexpr size_t WS_MOD = 1 * MiB;
constexpr size_t WS_ST = WS_MOD + 768 * 1024;
constexpr size_t WS_PART = 2 * MiB;
constexpr size_t WS_WIN = 20 * MiB, SZ_WIN = 192 * MiB;
constexpr size_t WS_WAB = 404 * MiB, SZ_WAB = 32 * MiB;
constexpr size_t WS_WO = 468 * MiB, SZ_WO = 32 * MiB;
constexpr size_t WS_WUP = 532 * MiB, SZ_WUP = 128 * MiB;
constexpr size_t WS_WDN = 788 * MiB, SZ_WDN = 128 * MiB;
constexpr size_t WS_U = 1044 * MiB;
constexpr size_t WS_P = 1112 * MiB;
constexpr size_t WS_QT = 1520 * MiB;
constexpr size_t WS_KBT = 1588 * MiB;
constexpr size_t WS_VT = 1656 * MiB;
constexpr size_t WS_ATT = 1690 * MiB;
constexpr size_t WS_EXPB = 1707 * MiB;
constexpr size_t WS_OF = 1716 * MiB;
constexpr size_t WS_OB = 1784 * MiB;
constexpr size_t WS_OAZB = 1852 * MiB;
constexpr size_t WS_YPRE = 1920 * MiB;
constexpr size_t WS_R = 1988 * MiB;
constexpr size_t WS_X1 = 2124 * MiB;
constexpr size_t WS_X2 = 2260 * MiB;
constexpr size_t WS_H = 2396 * MiB;
constexpr size_t WS_YPART = 2668 * MiB;
constexpr size_t WS_END = 2736 * MiB;
constexpr size_t WS_SLAB = WS_QT;
static_assert(WS_PART + (size_t)2 * KSPLIT * 3 * NIN * 4 <= WS_WIN && WS_WIN + 2 * SZ_WIN <= WS_WAB && WS_WAB + 2 * SZ_WAB <= WS_WO && WS_WO + 2 * SZ_WO <= WS_WUP && WS_WUP + 2 * SZ_WUP <= WS_WDN && WS_WDN + 2 * SZ_WDN <= WS_U, "ws map (weights)");
static_assert(WS_U + (size_t)MR * D * 2 <= WS_P && WS_P + (size_t)MR * NIN * 2 <= WS_QT && WS_QT + (size_t)NKB * 16 * 2 * 4096 <= WS_KBT && WS_KBT + (size_t)NKB * 16 * 2 * 4096 <= WS_VT && WS_VT + (size_t)NKB * 16 * 4096 <= WS_ATT, "ws map (act 1)");
static_assert(WS_ATT + (size_t)NKB * 16 * 2 * 1024 <= WS_EXPB && WS_EXPB + (size_t)NKB * 16 * 2 * 512 <= WS_OF && WS_OF + (size_t)MR * WA * 4 <= WS_OB && WS_OB + (size_t)MR * WA * 4 <= WS_OAZB && WS_OAZB + (size_t)MR * D * 2 <= WS_YPRE, "ws map (act 2)");
static_assert(WS_YPRE + (size_t)MR * D * 2 <= WS_R && WS_R + (size_t)MR * D * 4 <= WS_X1 && WS_X1 + (size_t)MR * D * 4 <= WS_X2 && WS_X2 + (size_t)MR * D * 4 <= WS_H && WS_H + (size_t)MR * DFF * 2 <= WS_END, "ws map (act 3)");
constexpr int CW_BAR = 4096;

constexpr int RING_OFF = 0, RING_BYTES = 131072;
constexpr int LDSCTL_OFF = RING_BYTES, MISC_OFF = LDSCTL_OFF + 320;
constexpr int LDS_BYTES = 147456;

#define GAS __attribute__((address_space(1)))
#define CAS __attribute__((address_space(4)))
#define LAS __attribute__((address_space(3)))
#define DI __device__ __forceinline__
typedef unsigned short bf16;
typedef unsigned v4u __attribute__((ext_vector_type(4)));
typedef unsigned v2u __attribute__((ext_vector_type(2)));
typedef float f32x4 __attribute__((ext_vector_type(4)));
typedef float f32x2 __attribute__((ext_vector_type(2)));
typedef float f32x16 __attribute__((ext_vector_type(16)));
typedef short bf16x8 __attribute__((ext_vector_type(8)));
typedef GAS unsigned gu32;
#define RLX_AGENT __ATOMIC_RELAXED, __HIP_MEMORY_SCOPE_AGENT
#define LDS_WAIT() asm volatile("s_waitcnt lgkmcnt(0)" ::: "memory")
#define VM_WAIT() asm volatile("s_waitcnt vmcnt(0)" ::: "memory")
#define MFMA32(a, b, c) __builtin_amdgcn_mfma_f32_32x32x16_bf16((a), (b), (c), 0, 0, 0)
DI unsigned f2bf(float f) { unsigned u = __builtin_bit_cast(unsigned, f); return (u + 0x7fffu + ((u >> 16) & 1u)) >> 16; }
typedef __bf16 bf16x2_t __attribute__((ext_vector_type(2)));
DI unsigned pk2(float lo, float hi) { const f32x2 v = {lo, hi}; return __builtin_bit_cast(unsigned, __builtin_convertvector(v, bf16x2_t)); }
DI float bflo(unsigned w) { return __uint_as_float(w << 16); }
DI float bfhi(unsigned w) { return __uint_as_float(w & 0xffff0000u); }
constexpr float L2E = 1.44269504088896341f;
DI float ex2(float x) { return __builtin_amdgcn_exp2f(x); }
DI float sigmoidf_(float x) { return __builtin_amdgcn_rcpf(1.f + ex2(-L2E * x)); }
DI int sigma16(int p) { return 8 * ((p >> 2) & 1) + 4 * (p >> 3) + (p & 3); }

#define XB_TMO      128
#define XB_XCNT(j)  (256  + 64 * (j))
#define XB_XSUB(j)  (1280 + 64 * (j))
#define XB_XGEN(j)  (2304 + 64 * (j))
#define XB_TOP      3328
#define XB_TOPGEN   3392
#define XCD_BAR_WORDS 3456
#define XB_SPIN_CAP (1u << 18)

__device__ __forceinline__ unsigned xb_ld(unsigned* p)              { return __hip_atomic_load(p, __ATOMIC_RELAXED, __HIP_MEMORY_SCOPE_AGENT); }
__device__ __forceinline__ unsigned xb_add(unsigned* p, unsigned v) { return __hip_atomic_fetch_add(p, v, __ATOMIC_RELAXED, __HIP_MEMORY_SCOPE_AGENT); }
__device__ __forceinline__ unsigned xb_xcc_id() { return (unsigned)__builtin_amdgcn_s_getreg((3 << 11) | 20) & 0xFu; }
#define XB_SPIN(cond, bar) do { unsigned _sp = 0; while (cond) { __builtin_amdgcn_s_sleep(1); \
    if ((++_sp & 255u) == 0u) { if (xb_ld(&(bar)[XB_TMO])) break; if (_sp > XB_SPIN_CAP) { atomicAdd(&(bar)[XB_TMO], 1u); break; } } } } while (0)

struct XcdBarrier {
    unsigned* bar; unsigned x;
    volatile LAS unsigned* st;
};

__device__ __forceinline__ XcdBarrier xcd_barrier_post(unsigned* bar, volatile LAS unsigned* st) {
    XcdBarrier b; b.bar = bar; b.x = xb_xcc_id(); b.st = st;
    if (threadIdx.x == 0) (void)xb_add(&bar[XB_XCNT(b.x)], 1u);
    return b;
}
__device__ __forceinline__ void xcd_barrier_complete(unsigned* bar, unsigned x, unsigned& nloc, unsigned& nx) {
    const unsigned G = gridDim.x * gridDim.y * gridDim.z;
    unsigned sum, cnt, mine, sp = 0u;
    for (;;) {
        sum = 0u; cnt = 0u; mine = 0u;
#pragma unroll
        for (unsigned j = 0; j < 16; ++j) { const unsigned c = xb_ld(&bar[XB_XCNT(j)]); sum += c; cnt += (c > 0u) ? 1u : 0u; mine = (j == x) ? c : mine; }
        if (sum == G) break;
        __builtin_amdgcn_s_sleep(1);
        if ((++sp & 255u) == 0u) { if (xb_ld(&bar[XB_TMO])) break; if (sp > XB_SPIN_CAP) { atomicAdd(&bar[XB_TMO], 1u); break; } }
    }
    nloc = mine > 0u ? mine : 1u; nx = cnt > 0u ? cnt : 1u;
}

__device__ __forceinline__ void xcd_barrier(const XcdBarrier& b) {
    asm volatile("s_waitcnt vmcnt(0)" ::: "memory");
    __syncthreads();
    if (threadIdx.x == 0) {
        unsigned* bar = b.bar;
        unsigned bx = b.x; asm volatile("" : "+s"(bx));
        __builtin_amdgcn_s_waitcnt(0);
        unsigned nloc = b.st[0], nx = b.st[1];
        if (nloc == 0u) { xcd_barrier_complete(bar, bx, nloc, nx); b.st[0] = nloc; b.st[1] = nx; }
        const unsigned old = xb_add(&bar[XB_XSUB(bx)], 1u);
        const unsigned gen = old / nloc;
        if (old + 1u == (gen + 1u) * nloc) {
            __builtin_amdgcn_fence(__ATOMIC_RELEASE, "agent");
            asm volatile("s_waitcnt vmcnt(0)" ::: "memory");
            const unsigned og = xb_add(&bar[XB_TOP], 1u);
            const unsigned tg = og / nx;
            if (og + 1u == (tg + 1u) * nx) xb_add(&bar[XB_TOPGEN], 1u);
            else XB_SPIN(xb_ld(&bar[XB_TOPGEN]) == tg, bar);
            __builtin_amdgcn_fence(__ATOMIC_ACQUIRE, "agent");
            xb_add(&bar[XB_XGEN(bx)], 1u);
            asm volatile("s_waitcnt vmcnt(0)" ::: "memory");
        } else {
            XB_SPIN(xb_ld(&bar[XB_XGEN(bx)]) == gen, bar);
            __builtin_amdgcn_fence(__ATOMIC_ACQUIRE, "agent");
            asm volatile("s_waitcnt vmcnt(0)" ::: "memory");
        }
    }
    __syncthreads();
}

struct Frame {
    LAS unsigned char* lds;
    volatile LAS unsigned* MISC;
    gu32* ctl;
    int tid, lane, wave;
    int G;
    unsigned char* ws;
};
DI float shfl_x(float v, int o, int lane) { return __int_as_float(__builtin_amdgcn_ds_bpermute((lane ^ o) << 2, __float_as_int(v))); }
DI float wave_sum(float v) {
#pragma unroll
    for (int o = 1; o < 64; o <<= 1) v += __shfl_xor(v, o);
    return v;
}
DI int row_vec(int row) { return row < SEQ ? 0 : (row < ML ? 1 : 2); }

struct P0Item { const float* src; bf16* dst; int N; };
DI void p0_load(const P0Item& it, int lane, f32x4 (&v)[8]) {
#pragma unroll
    for (int i = 0; i < 8; ++i) v[i] = *(const GAS f32x4*)(it.src + (size_t)(8 * i + (lane >> 3)) * it.N + (lane & 7) * 4);
}
DI void p0_emit(const P0Item& it, const f32x4 (&v)[8], LAS float* scr, int lane) {
#pragma unroll
    for (int i = 0; i < 8; ++i) { LAS float* w = scr + (8 * i + (lane >> 3)) * 33 + (lane & 7) * 4; w[0] = v[i][0]; w[1] = v[i][1]; w[2] = v[i][2]; w[3] = v[i][3]; }
    LDS_WAIT(); asm volatile("" ::: "memory");
#pragma unroll
    for (int jj = 0; jj < 4; ++jj) { const int q = 64 * jj + lane, n = q >> 3, c = q & 7; const LAS float* s = scr + (8 * c) * 33 + n;
        v4u o; o.x = pk2(s[0 * 33], s[1 * 33]); o.y = pk2(s[2 * 33], s[3 * 33]); o.z = pk2(s[4 * 33], s[5 * 33]); o.w = pk2(s[6 * 33], s[7 * 33]);
        *(GAS v4u*)(it.dst + (size_t)q * 8) = o; }
    LDS_WAIT(); asm volatile("" ::: "memory");
}
struct P0Args { const float *c, *c_ctx, *w_ada, *w_in, *w_out_a, *w_out_b, *w_o, *w_up, *w_down; };
constexpr int I_IN = (D / 64) * (NIN / 32), I_OA = (WA / 64) * (D / 32), I_O = (D / 64) * (D / 32), I_UP = (D / 64) * (DFF / 32), I_DN = (DFF / 64) * (D / 32);
constexpr int I_LAYER = I_IN + 2 * I_OA + I_O + I_UP + I_DN;
constexpr int BG_N1 = 9600  , BG_N3 = 15680  , BG_N4 = 19200  , BG_N5 = 9600  ;
constexpr int BG_S0 = I_LAYER - (BG_N1 + BG_N3 + BG_N4 + BG_N5);
constexpr int BG_S1 = BG_S0 + BG_N1, BG_S2 = BG_S1, BG_S3 = BG_S2 + BG_N3, BG_S4 = BG_S3 + BG_N4, BG_S5 = BG_S4 + BG_N5;
static_assert(BG_S0 >= I_IN && BG_S5 == I_LAYER, "layer 1's w_in is converted in the prologue (the last slot runs inside layer 1's w_in phase); the slots end the layer");
DI void convert_items(Frame& F, const P0Args& A, int lo, int hi, int gw, int NGW, LAS float* scr) {
    auto decode = [&](int itn, P0Item& o) {
        const int l = itn / I_LAYER; int r = itn % I_LAYER;
        const float* W; bf16* WT; int N, Ktot, koff = 0;
        if (r < I_IN) { W = A.w_in + (size_t)l * D * NIN; WT = (bf16*)(F.ws + WS_WIN + l * SZ_WIN); N = NIN; Ktot = D; }
        else if ((r -= I_IN) < I_OA) { W = A.w_out_a + (size_t)l * WA * D; WT = (bf16*)(F.ws + WS_WAB + l * SZ_WAB); N = D; Ktot = D; }
        else if ((r -= I_OA) < I_OA) { W = A.w_out_b + (size_t)l * WA * D; WT = (bf16*)(F.ws + WS_WAB + l * SZ_WAB); N = D; Ktot = D; koff = WA; }
        else if ((r -= I_OA) < I_O) { W = A.w_o + (size_t)l * D * D; WT = (bf16*)(F.ws + WS_WO + l * SZ_WO); N = D; Ktot = D; }
        else if ((r -= I_O) < I_UP) { W = A.w_up + (size_t)l * D * DFF; WT = (bf16*)(F.ws + WS_WUP + l * SZ_WUP); N = DFF; Ktot = D; }
        else { r -= I_UP; W = A.w_down + (size_t)l * DFF * D; WT = (bf16*)(F.ws + WS_WDN + l * SZ_WDN); N = D; Ktot = DFF; }
        const int nblk = N / 32, kb = r / nblk, nb = r % nblk, k0 = 64 * kb, n0 = 32 * nb;
        o.src = W + (size_t)k0 * N + n0; o.N = N;
        o.dst = WT + (((size_t)(n0 >> 8) * (Ktot / 64) + ((koff + k0) >> 6)) * 256 + (n0 & 255)) * 64;
    };
    int itn = lo + gw; P0Item ia, ib; f32x4 va[8], vb[8];
    if (itn < hi) { decode(itn, ia); p0_load(ia, F.lane, va); }
    while (itn < hi) {
        const int i2 = itn + NGW; if (i2 < hi) { decode(i2, ib); p0_load(ib, F.lane, vb); }
        p0_emit(ia, va, scr, F.lane);
        if (i2 >= hi) break;
        const int i3 = i2 + NGW; if (i3 < hi) { decode(i3, ia); p0_load(ia, F.lane, va); }
        p0_emit(ib, vb, scr, F.lane);
        itn = i3;
    }
}
DI void bg_convert(Frame& F, const P0Args& A, int wg0, int lo, int hi) {
    if ((int)blockIdx.x < wg0) return;
    const int gw = ((int)blockIdx.x - wg0) * NWAVES + F.wave, NGW = (F.G - wg0) * NWAVES;
    convert_items(F, A, I_LAYER + lo, I_LAYER + hi, gw, NGW, (LAS float*)(F.lds + RING_OFF + F.wave * 16384));
}
DI void phase0(Frame& F, const P0Args& A) {
    LAS float* sv = (LAS float*)(F.lds + RING_OFF);
    for (int i = F.tid; i < 3 * D; i += NWAVES * 64) { const int v = i / D, k = i % D; const float x = v < 2 ? A.c[v * D + k] : A.c_ctx[k]; sv[i] = x * sigmoidf_(x); }
    __syncthreads();
    const int gw = blockIdx.x * NWAVES + F.wave, NGW = F.G * NWAVES;
    float* part = (float*)(F.ws + WS_PART);
    constexpr int NCG = NIN / 256, NTASK = 2 * KSPLIT * NCG;
    for (int tk = gw; tk < NTASK; tk += NGW) {
        const int l = tk / (KSPLIT * NCG), rem = tk % (KSPLIT * NCG), kc = rem / NCG, cg = rem % NCG;
        const int n0 = cg * 256 + F.lane * 4, k0 = kc * (D / KSPLIT);
        const float* wp = A.w_ada + ((size_t)l * D + k0) * NIN + n0;
        f32x4 a0 = {0.f, 0.f, 0.f, 0.f}, a1 = a0, a2 = a0;
#pragma unroll 8
        for (int k = 0; k < D / KSPLIT; ++k) { const f32x4 w = *(const GAS f32x4*)(wp + (size_t)k * NIN);
            a0 += w * sv[k0 + k]; a1 += w * sv[D + k0 + k]; a2 += w * sv[2 * D + k0 + k]; }
        float* pp = part + ((size_t)(l * KSPLIT + kc) * 3) * NIN + n0;
        *(f32x4*)(pp) = a0; *(f32x4*)(pp + NIN) = a1; *(f32x4*)(pp + 2 * NIN) = a2;
    }
    __syncthreads();
    convert_items(F, A, 0, I_LAYER, gw, NGW, (LAS float*)(F.lds + RING_OFF + F.wave * 16384));
    convert_items(F, A, I_LAYER, I_LAYER + BG_S0, gw, NGW, (LAS float*)(F.lds + RING_OFF + F.wave * 16384));
}
DI void phase1(Frame& F, const float* b_ada) {
    const float* part = (const float*)(F.ws + WS_PART); float* mod = (float*)(F.ws + WS_MOD);
    for (int i = blockIdx.x * (NWAVES * 64) + F.tid; i < 2 * 3 * NIN; i += F.G * NWAVES * 64) {
        const int l = i / (3 * NIN), rem = i % (3 * NIN), v = rem / NIN, n = rem % NIN;
        float s = b_ada[l * NIN + n];
#pragma unroll 8
        for (int kc = 0; kc < KSPLIT; ++kc) s += part[((size_t)(l * KSPLIT + kc) * 3 + v) * NIN + n];
        mod[i] = s;
    }
}
DI void phase_modulate0(Frame& F, const float* x, const float* ctx) {
    const float* mod = (const float*)(F.ws + WS_MOD); bf16* U = (bf16*)(F.ws + WS_U);
    const int gw = blockIdx.x * NWAVES + F.wave, NGW = F.G * NWAVES;
    for (int row = gw; row < MR; row += NGW) {
        const float* xr = row < ML ? x + (size_t)row * D : ctx + (size_t)(row - ML) * D;
        const float* mv = mod + row_vec(row) * NIN;
        bf16* ur = U + (size_t)row * D;
#pragma unroll 4
        for (int j = 0; j < 16; ++j) { const int c = j * 256 + F.lane * 4;
            const f32x4 v = *(const GAS f32x4*)(xr + c), sh = *(const f32x4*)(mv + c), sc = *(const f32x4*)(mv + D + c);
            const f32x4 o = v * (sc + 1.f) + sh; v2u w; w.x = pk2(o[0], o[1]); w.y = pk2(o[2], o[3]); *(GAS v2u*)(ur + c) = w; }
    }
}
template <bool HAS_MOD, bool CTX_SPLIT>
DI void phase_ln(Frame& F, const float* R, const float* g, const float* b, float* xo, int xo_from  , float* st  , int nrows, const float* mv_base  , int sh_off, int sc_off,
                 const float* slab  , const float* xres_ctx  , const float* gate_ctx  ) {
    bf16* U = (bf16*)(F.ws + WS_U);
    LAS float* red1 = (LAS float*)(F.lds + RING_OFF); LAS float* red2 = red1 + 64;
    const int nlat = CTX_SPLIT ? ML / F.G : 0, nctx = CTX_SPLIT ? MC / F.G : 0;
    const int rpw = CTX_SPLIT ? nlat + nctx : (nrows + F.G - 1) / F.G, row0 = blockIdx.x * rpw;
#define LN_ROW(k) (CTX_SPLIT ? ((k) < nlat ? (int)blockIdx.x * nlat + (k) : ML + (int)blockIdx.x * nctx + ((k) - nlat)) : row0 + (k))
    const int c0 = F.wave * 512 + F.lane * 8;
    f32x4 gc0 = {0.f, 0.f, 0.f, 0.f}, gc1 = gc0;
    if (CTX_SPLIT) { gc0 = *(const f32x4*)(gate_ctx + c0); gc1 = *(const f32x4*)(gate_ctx + c0 + 4); }
    const f32x4 g0 = *(const f32x4*)(g + c0), g1 = *(const f32x4*)(g + c0 + 4), b0 = *(const f32x4*)(b + c0), b1 = *(const f32x4*)(b + c0 + 4);
    f32x4 sc0 = {0.f, 0.f, 0.f, 0.f}, sc1 = sc0, sh0 = sc0, sh1 = sc0; int cur_vec = -1;
    auto ln_load = [&](int rb, f32x4 (&v)[8][2]) {
#pragma unroll
        for (int i = 0; i < 8; ++i) { const int row = LN_ROW(rb + i); const bool ok = (rb + i < rpw) && row < nrows;
            if (ok && CTX_SPLIT && row >= ML) { const size_t ro = (size_t)(row - ML) * D + c0;
                f32x4 a0 = *(const GAS f32x4*)(slab + ro), a1 = *(const GAS f32x4*)(slab + ro + 4);
#pragma unroll
                for (int kc = 1; kc < 8; ++kc) { a0 += *(const GAS f32x4*)(slab + (size_t)kc * MC * D + ro); a1 += *(const GAS f32x4*)(slab + (size_t)kc * MC * D + ro + 4); }
                v[i][0] = *(const GAS f32x4*)(xres_ctx + ro) * ALPHA + gc0 * a0; v[i][1] = *(const GAS f32x4*)(xres_ctx + ro + 4) * ALPHA + gc1 * a1; }
            else if (ok) { const float* rr = R + (size_t)row * D + c0; v[i][0] = *(const GAS f32x4*)rr; v[i][1] = *(const GAS f32x4*)(rr + 4); }
            else { v[i][0] = (f32x4){0.f, 0.f, 0.f, 0.f}; v[i][1] = v[i][0]; } }
    };
    auto ln_process = [&](int rb, f32x4 (&v)[8][2]) {
        float s[8];
#pragma unroll
        for (int i = 0; i < 8; ++i) s[i] = ((v[i][0][0] + v[i][0][1]) + (v[i][0][2] + v[i][0][3])) + ((v[i][1][0] + v[i][1][1]) + (v[i][1][2] + v[i][1][3]));
#pragma unroll
        for (int o = 1; o < 64; o <<= 1) {
#pragma unroll
            for (int i = 0; i < 8; ++i) s[i] += shfl_x(s[i], o, F.lane); }
        if (F.lane < 8) { float t = s[0];
#pragma unroll
            for (int i = 1; i < 8; ++i) t = F.lane == i ? s[i] : t;
            red1[F.lane * 8 + F.wave] = t; }
        __syncthreads();
        float mean[8];
#pragma unroll
        for (int i = 0; i < 8; ++i) { const f32x4 p0 = *(const LAS f32x4*)(red1 + i * 8), p1 = *(const LAS f32x4*)(red1 + i * 8 + 4);
            mean[i] = (((p0[0] + p0[1]) + (p0[2] + p0[3])) + ((p1[0] + p1[1]) + (p1[2] + p1[3]))) * (1.f / D); }
#pragma unroll
        for (int i = 0; i < 8; ++i) { v[i][0] = v[i][0] - mean[i]; v[i][1] = v[i][1] - mean[i];
            s[i] = ((v[i][0][0] * v[i][0][0] + v[i][0][1] * v[i][0][1]) + (v[i][0][2] * v[i][0][2] + v[i][0][3] * v[i][0][3])) + ((v[i][1][0] * v[i][1][0] + v[i][1][1] * v[i][1][1]) + (v[i][1][2] * v[i][1][2] + v[i][1][3] * v[i][1][3])); }
#pragma unroll
        for (int o = 1; o < 64; o <<= 1) {
#pragma unroll
            for (int i = 0; i < 8; ++i) s[i] += shfl_x(s[i], o, F.lane); }
        if (F.lane < 8) { float t = s[0];
#pragma unroll
            for (int i = 1; i < 8; ++i) t = F.lane == i ? s[i] : t;
            red2[F.lane * 8 + F.wave] = t; }
        __syncthreads();
#pragma unroll
        for (int i = 0; i < 8; ++i) { const int row = LN_ROW(rb + i); const bool ok = (rb + i < rpw) && row < nrows;
            const f32x4 p0 = *(const LAS f32x4*)(red2 + i * 8), p1 = *(const LAS f32x4*)(red2 + i * 8 + 4);
            const float var = (((p0[0] + p0[1]) + (p0[2] + p0[3])) + ((p1[0] + p1[1]) + (p1[2] + p1[3]))) * (1.f / D);
            const float rstd = 1.f / sqrtf(var + LN_EPS);
            if (ok) {
                const f32x4 y0 = v[i][0] * rstd * g0 + b0, y1 = v[i][1] * rstd * g1 + b1;
                if (row >= xo_from) { float* xr = xo + (size_t)row * D + c0; *(GAS f32x4*)xr = y0; *(GAS f32x4*)(xr + 4) = y1; }
                if (st && F.tid == 0) *(GAS f32x2*)(st + (size_t)row * 2) = (f32x2){mean[i], rstd};
                if (HAS_MOD) { const int vec = row_vec(row);
                    if (vec != cur_vec) { const float* mv = mv_base + vec * NIN + c0; sc0 = *(const f32x4*)(mv + sc_off); sc1 = *(const f32x4*)(mv + sc_off + 4); sh0 = *(const f32x4*)(mv + sh_off); sh1 = *(const f32x4*)(mv + sh_off + 4); cur_vec = vec; }
                    const f32x4 o0 = y0 * (sc0 + 1.f) + sh0, o1 = y1 * (sc1 + 1.f) + sh1;
                    v4u w; w.x = pk2(o0[0], o0[1]); w.y = pk2(o0[2], o0[3]); w.z = pk2(o1[0], o1[1]); w.w = pk2(o1[2], o1[3]);
                    *(GAS v4u*)(U + (size_t)row * D + c0) = w; } } }
    };
    f32x4 va[8][2], vb[8][2];
    ln_load(0, va);
    for (int rb = 0; rb < rpw; rb += 16) {
        if (rb + 8 < rpw) ln_load(rb + 8, vb);
        ln_process(rb, va);
        if (rb + 8 >= rpw) break;
        if (rb + 16 < rpw) ln_load(rb + 16, va);
        ln_process(rb + 8, vb);
    }
    __syncthreads();
#undef LN_ROW
}
DI void prep_task(Frame& F, const bf16* P, const float* lbnd  , int layer, int kb, int head, LAS unsigned char* wl  , int nost  ) {
    const int lane = F.lane;
    const bf16* prow = P + (size_t)(16 * kb) * NIN + head * DK + 2 * lane;
    unsigned zf[16], zb[16], qq[16], vv[16];
#pragma unroll
    for (int t = 0; t < 16; ++t) { const bf16* pr = prow + (size_t)t * NIN;
        zf[t] = *(const GAS unsigned*)(pr + C_FF); zb[t] = *(const GAS unsigned*)(pr + C_FB); qq[t] = *(const GAS unsigned*)(pr + C_Q); vv[t] = *(const GAS unsigned*)(pr + C_I); }
    const size_t kh = (size_t)kb * 16 + head;
    {
        unsigned lo[8], hi[8];
#pragma unroll
        for (int m = 0; m < 8; ++m) { const int s0 = sigma16(2 * m); lo[m] = (vv[s0] & 0xffffu) | (vv[s0 + 1] << 16); hi[m] = (vv[s0] >> 16) | (vv[s0 + 1] & 0xffff0000u); }
        GAS v4u* o = (GAS v4u*)(F.ws + WS_VT + kh * 4096 + (size_t)(2 * lane) * 32);
        if (!nost) { o[0] = (v4u){lo[0], lo[1], lo[2], lo[3]}; o[1] = (v4u){lo[4], lo[5], lo[6], lo[7]}; o[2] = (v4u){hi[0], hi[1], hi[2], hi[3]}; o[3] = (v4u){hi[4], hi[5], hi[6], hi[7]}; }
    }
    float qs0[16], qs1[16];
#pragma unroll
    for (int t = 0; t < 16; ++t) { const float a = bflo(qq[t]), b = bfhi(qq[t]); qs0[t] = a * sigmoidf_(a); qs1[t] = b * sigmoidf_(b); }
    LAS unsigned char* lq = wl; LAS unsigned char* lk = wl + 16 * 272;
    const int d0 = 2 * lane, dpos = 16 * (d0 >> 4) + sigma16(d0 & 15);
    const int dl = d0 & 31, epos = (d0 >> 5) * 32 + ((dl >> 2) & 1) * 16 + ((dl & 3) | ((dl >> 3) << 2));
#pragma unroll
    for (int dir = 0; dir < 2; ++dir) {
        const size_t idx = kh * 2 + dir;
        float lb0 = 0.f, lb1 = 0.f;
        if (layer == 1) { const float* lp = lbnd + dir * WA + head * DK + d0;
            lb0 = __builtin_amdgcn_rcpf(1.f + ex2(L2E * (lp[0] - lp[2 * WA]))); lb1 = __builtin_amdgcn_rcpf(1.f + ex2(L2E * (lp[1] - lp[2 * WA + 1]))); }
        float b0[16], b1[16], k0[16], k1[16]; float c0 = 0.f, c1 = 0.f;
#pragma unroll
        for (int i = 0; i < 16; ++i) { const int t = dir ? 15 - i : i; const unsigned zw = dir ? zb[t] : zf[t];
            const float z0 = bflo(zw), z1 = bfhi(zw);
            const float e0 = ex2(-L2E * fabsf(z0)), e1 = ex2(-L2E * fabsf(z1)), r0 = __builtin_amdgcn_rcpf(1.f + e0), r1 = __builtin_amdgcn_rcpf(1.f + e1);
            const float sp0 = z0 >= 0.f ? r0 : e0 * r0, sm0 = z0 >= 0.f ? e0 * r0 : r0, sp1 = z1 >= 0.f ? r1 : e1 * r1, sm1 = z1 >= 0.f ? e1 * r1 : r1;
            c0 += __builtin_amdgcn_logf(fmaxf(lb0 + (1.f - lb0) * sp0, 1e-37f)); c1 += __builtin_amdgcn_logf(fmaxf(lb1 + (1.f - lb1) * sp1, 1e-37f));
            b0[t] = c0; b1[t] = c1; k0[t] = (1.f - lb0) * sm0; k1[t] = (1.f - lb1) * sm1; }
        float kb0[16], kb1[16];
#pragma unroll
        for (int t = 0; t < 16; ++t) {
            const float eb0 = ex2(b0[t]), eb1 = ex2(b1[t]);
            const unsigned qt = pk2(qs0[t] * eb0, qs1[t] * eb1);
            const unsigned kt = pk2(k0[t] * ex2(fminf(-b0[t], 115.f)), k1[t] * ex2(fminf(-b1[t], 115.f)));
            kb0[t] = k0[t] * ex2(c0 - b0[t]); kb1[t] = k1[t] * ex2(c1 - b1[t]);
            *(LAS unsigned*)(lq + t * 272 + 4 * lane) = qt; *(LAS unsigned*)(lk + t * 272 + 4 * lane) = kt;
            if (!nost) *(GAS unsigned*)(F.ws + WS_QT + idx * 4096 + (size_t)t * 256 + dpos * 2) = qt; }
        {
            unsigned w0[8], w1[8];
#pragma unroll
            for (int m = 0; m < 8; ++m) { const int s0 = sigma16(2 * m); w0[m] = pk2(kb0[s0], kb0[s0 + 1]); w1[m] = pk2(kb1[s0], kb1[s0 + 1]); }
            GAS v4u* o = (GAS v4u*)(F.ws + WS_KBT + idx * 4096 + (size_t)d0 * 32);
            if (!nost) { o[0] = (v4u){w0[0], w0[1], w0[2], w0[3]}; o[1] = (v4u){w0[4], w0[5], w0[6], w0[7]}; o[2] = (v4u){w1[0], w1[1], w1[2], w1[3]}; o[3] = (v4u){w1[4], w1[5], w1[6], w1[7]}; }
        }
        if (!nost) *(GAS f32x2*)(F.ws + WS_EXPB + idx * 512 + (size_t)epos * 4) = (f32x2){ex2(c0), ex2(c1)};
        LDS_WAIT(); asm volatile("" ::: "memory");
        const int r = lane & 31, hh = lane >> 5;
        f32x16 X;
#pragma unroll
        for (int i = 0; i < 16; ++i) X[i] = 0.f;
#pragma unroll
        for (int ks = 0; ks < 8; ++ks) { const int off = (r & 15) * 272 + (16 * ks + 8 * hh) * 2;
            const bf16x8 ak = *(const LAS bf16x8*)(lk + off), bq = *(const LAS bf16x8*)(lq + off); X = MFMA32(ak, bq, X); }
        unsigned aw[4];
#pragma unroll
        for (int w = 0; w < 4; ++w) { const int j0 = 2 * w, j1 = 2 * w + 1, s0 = (j0 & 3) + 8 * (j0 >> 2) + 4 * hh, s1 = (j1 & 3) + 8 * (j1 >> 2) + 4 * hh;
            const bool k0_ = r < 16 && (dir ? s0 >= r : s0 <= r), k1_ = r < 16 && (dir ? s1 >= r : s1 <= r);
            aw[w] = pk2(k0_ ? X[j0] : 0.f, k1_ ? X[j1] : 0.f); }
        if (!nost) *(GAS v4u*)(F.ws + WS_ATT + idx * 1024 + (size_t)lane * 16) = (v4u){aw[0], aw[1], aw[2], aw[3]};
        asm volatile("" ::: "memory");
    }
}
constexpr int SC_Q = 0, SC_K = 4096, SC_V = 8192, SC_A = 12288, SC_E = 13312, SC_SLOT = 13824, SC_NSLOT = 8, SC_PD = SC_NSLOT - 1  , SC_WGS = 64, SC_NSTEP = 16 + 256;
DI int scan_kb(int j, int b, int dir) { if (j < 16) return 512 + 16 * b + (dir ? 15 - j : j); const int jj = j - 16; return 256 * b + (dir ? 255 - jj : jj); }
DI void scan_issue(const unsigned char* ws, LAS unsigned char* slot, int kb, int head, int dir, int h  , int lane) {
    const size_t kh = (size_t)kb * 16 + head, idx = kh * 2 + dir;
    __builtin_amdgcn_global_load_lds((const unsigned*)(ws + WS_QT + idx * 4096 + (size_t)((lane & 15) * 256 + (4 * h + (lane >> 4)) * 16)), (LAS unsigned*)(slot + SC_Q + h * 1024), 16, 0, 0);
    const size_t ro = (size_t)((64 * (h & 1) + lane) * 32 + (h >> 1) * 16);
    __builtin_amdgcn_global_load_lds((const unsigned*)(ws + WS_KBT + idx * 4096 + ro), (LAS unsigned*)(slot + SC_K + h * 1024), 16, 0, 0);
    __builtin_amdgcn_global_load_lds((const unsigned*)(ws + WS_VT + kh * 4096 + ro), (LAS unsigned*)(slot + SC_V + h * 1024), 16, 0, 0);
    if (h == 1 || h == 2) __builtin_amdgcn_global_load_lds((const unsigned*)(ws + WS_EXPB + idx * 512 + (size_t)(h - 1) * 256 + (size_t)lane * 4), (LAS unsigned*)(slot + SC_E + (h - 1) * 256), 4, 0, 0);
    else __builtin_amdgcn_global_load_lds((const unsigned*)(ws + WS_ATT + idx * 1024 + (size_t)lane * 16), (LAS unsigned*)(slot + SC_A), 16, 0, 0);
}
DI bf16x8 pack_rows(const f32x16& x, int s) {
    v4u p; p.x = pk2(x[8 * s], x[8 * s + 1]); p.y = pk2(x[8 * s + 2], x[8 * s + 3]); p.z = pk2(x[8 * s + 4], x[8 * s + 5]); p.w = pk2(x[8 * s + 6], x[8 * s + 7]);
    return __builtin_bit_cast(bf16x8, p);
}
DI void scan_step(f32x16 (&S)[4], const LAS unsigned char* slot, int vg, bf16* orow  , int lane) {
    const int r = lane & 31, hh = lane >> 5;
    const LAS unsigned char* qp = slot + SC_Q + (hh * 16 + (r & 15)) * 16;
    const LAS unsigned char* kp = slot + SC_K + (hh * 128 + r) * 16;
    const LAS f32x4* ep = (const LAS f32x4*)(slot + SC_E + hh * 64);
    bf16x8 qf[8], kf[4]; f32x4 e[4][4];
#pragma unroll
    for (int ks = 0; ks < 8; ++ks) qf[ks] = *(const LAS bf16x8*)(qp + ks * 512);
    const bf16x8 af = *(const LAS bf16x8*)(slot + SC_A + lane * 16), vf = *(const LAS bf16x8*)(slot + SC_V + (hh * 128 + 32 * vg + r) * 16);
#pragma unroll
    for (int dt = 0; dt < 4; ++dt) { kf[dt] = *(const LAS bf16x8*)(kp + dt * 512);
#pragma unroll
        for (int g = 0; g < 4; ++g) e[dt][g] = ep[dt * 8 + g]; }
    asm volatile("" ::: "memory");
    f32x16 O;
#pragma unroll
    for (int i = 0; i < 16; ++i) O[i] = 0.f;
#pragma unroll
    for (int dt = 0; dt < 4; ++dt)
#pragma unroll
        for (int s2 = 0; s2 < 2; ++s2) O = MFMA32(qf[2 * dt + s2], pack_rows(S[dt], s2), O);
    O = MFMA32(af, vf, O);
#pragma unroll
    for (int dt = 0; dt < 4; ++dt) {
#pragma unroll
        for (int c = 0; c < 4; ++c) { S[dt][c] *= e[dt][0][c]; S[dt][4 + c] *= e[dt][1][c]; S[dt][8 + c] *= e[dt][2][c]; S[dt][12 + c] *= e[dt][3][c]; }
        S[dt] = MFMA32(kf[dt], vf, S[dt]);
    }
#pragma unroll
    for (int i = 0; i < 8; i += 2) { const unsigned w = pk2(O[i], O[i + 1]);
        *(GAS bf16*)(orow + (size_t)((i & 3) + 8 * (i >> 2) + 4 * hh) * WA) = (bf16)(w & 0xffffu); *(GAS bf16*)(orow + (size_t)(((i + 1) & 3) + 8 * ((i + 1) >> 2) + 4 * hh) * WA) = (bf16)(w >> 16); }
}
#define SC_WAIT(n) asm volatile("s_waitcnt vmcnt(" #n ")" ::: "memory")
#define SC_WAITN(n) asm volatile("s_waitcnt vmcnt(%0)" :: "n"(n) : "memory")
#define SC_BAR() do { asm volatile("" ::: "memory"); __builtin_amdgcn_s_barrier(); asm volatile("" ::: "memory"); } while (0)
DI void scan_wg(Frame& F, int stream) {
    const int lane = F.lane, dir = stream & 1, head = (stream >> 1) & 15, b = stream >> 5;
    LAS unsigned char* ring = F.lds + RING_OFF;
    if (F.wave >= 4) {
        const int h = F.wave - 4;
#pragma unroll
        for (int i = 0; i < SC_PD; ++i) scan_issue(F.ws, ring + i * SC_SLOT, scan_kb(i, b, dir), head, dir, h, lane);
        SC_WAITN(4 * (SC_PD - 1)); SC_BAR();
        for (int j = 0; j < SC_NSTEP; ++j) {
            const int jn = j + SC_PD < SC_NSTEP ? j + SC_PD : SC_NSTEP - 1;
            scan_issue(F.ws, ring + ((j + SC_PD) & (SC_NSLOT - 1)) * SC_SLOT, scan_kb(jn, b, dir), head, dir, h, lane);
            SC_WAITN(4 * (SC_PD - 1)); SC_BAR();
        }
        SC_WAIT(0);
    } else {
        const int vg = F.wave, r = lane & 31;
        bf16* obase = (bf16*)(F.ws + (dir ? WS_OB : WS_OF)) + head * DK + 32 * vg + r;
        f32x16 S[4];
#pragma unroll
        for (int dt = 0; dt < 4; ++dt)
#pragma unroll
            for (int i = 0; i < 16; ++i) S[dt][i] = 0.f;
        SC_BAR();
        for (int j = 0; j < SC_NSTEP; ++j) {
            scan_step(S, ring + (j & (SC_NSLOT - 1)) * SC_SLOT, vg, obase + (size_t)(16 * scan_kb(j, b, dir)) * WA, lane);
            SC_BAR();
        }
    }
}
DI void conv_strip(Frame& F, const float* cw  , int task) {
    const bf16* P = (const bf16*)(F.ws + WS_P); bf16* OZ = (bf16*)(F.ws + WS_OAZB);
    const int strip = task >> 2, ch = (task & 3) * 512 + F.lane * 8, row0 = strip * 8;
    const bool hp = row0 < ML ? (row0 & 63) != 0 : ((row0 - ML) & (CTXL - 1)) != 0;
    const bool hn = row0 < ML ? ((row0 + 8) & 63) != 0 : ((row0 + 8 - ML) & (CTXL - 1)) != 0;
    const bf16* pr = P + (size_t)row0 * NIN + ch;
    v4u cg[10], hg[10], bg[8];
#pragma unroll
    for (int j = 0; j < 10; ++j) { const bool ok = j == 0 ? hp : (j == 9 ? hn : true);
        if (ok) { cg[j] = *(const GAS v4u*)(pr + (ptrdiff_t)(j - 1) * NIN + C_CG); hg[j] = *(const GAS v4u*)(pr + (ptrdiff_t)(j - 1) * NIN + C_H); }
        else { cg[j] = (v4u){0u, 0u, 0u, 0u}; hg[j] = cg[j]; } }
#pragma unroll
    for (int i = 0; i < 8; ++i) bg[i] = *(const GAS v4u*)(pr + (size_t)i * NIN + C_BG);
    float w0[8], w1[8], w2[8];
#pragma unroll
    for (int q = 0; q < 2; ++q) { const f32x4 a = *(const f32x4*)(cw + ch + 4 * q), b = *(const f32x4*)(cw + WA + ch + 4 * q), c = *(const f32x4*)(cw + 2 * WA + ch + 4 * q);
#pragma unroll
        for (int k = 0; k < 4; ++k) { w0[4 * q + k] = a[k]; w1[4 * q + k] = b[k]; w2[4 * q + k] = c[k]; } }
    float zm[8], z0[8], zp[8];
#pragma unroll
    for (int w = 0; w < 4; ++w) { zm[2 * w] = bflo(cg[0][w]) * bflo(hg[0][w]); zm[2 * w + 1] = bfhi(cg[0][w]) * bfhi(hg[0][w]); z0[2 * w] = bflo(cg[1][w]) * bflo(hg[1][w]); z0[2 * w + 1] = bfhi(cg[1][w]) * bfhi(hg[1][w]); }
#pragma unroll
    for (int i = 0; i < 8; ++i) {
#pragma unroll
        for (int w = 0; w < 4; ++w) { zp[2 * w] = bflo(cg[i + 2][w]) * bflo(hg[i + 2][w]); zp[2 * w + 1] = bfhi(cg[i + 2][w]) * bfhi(hg[i + 2][w]); }
        unsigned ow[4];
#pragma unroll
        for (int w = 0; w < 4; ++w) {
            const float yl = w0[2 * w] * zm[2 * w] + w1[2 * w] * z0[2 * w] + w2[2 * w] * zp[2 * w], yh = w0[2 * w + 1] * zm[2 * w + 1] + w1[2 * w + 1] * z0[2 * w + 1] + w2[2 * w + 1] * zp[2 * w + 1];
            ow[w] = pk2(bflo(bg[i][w]) * yl, bfhi(bg[i][w]) * yh); }
        *(GAS v4u*)(OZ + (size_t)(row0 + i) * D + WA + ch) = (v4u){ow[0], ow[1], ow[2], ow[3]};
#pragma unroll
        for (int k = 0; k < 8; ++k) { zm[k] = z0[k]; z0[k] = zp[k]; }
    }
}
DI void phase_prep(Frame& F, const float* lbnd, int layer, const float* cw, int flags) {
    const bf16* P = (const bf16*)(F.ws + WS_P);
    const int gw = blockIdx.x * NWAVES + F.wave, NGW = F.G * NWAVES;
    LAS unsigned char* wl = F.lds + RING_OFF + F.wave * 16384;
    for (int tk = gw; tk < NKB * NHEAD; tk += NGW) prep_task(F, P, lbnd, layer, tk >> 4, tk & 15, wl, flags & 1024);
    if (!(flags & 2048)) for (int tk = gw; tk < (MR / 8) * 4; tk += NGW) conv_strip(F, cw, tk);
}
template <class GemmFn>
DI void phase_scan_gemm(Frame& F, int flags, const GemmFn& zb_gemm) {
    const int nsc = F.G >= 2 * SC_WGS ? SC_WGS : 0;
    if (nsc) {
        if ((int)blockIdx.x < nsc) { if (!(flags & 1)) scan_wg(F, (int)blockIdx.x); }
        else if (!(flags & 2)) zb_gemm(F.G - nsc, (int)blockIdx.x - nsc);
    } else {
        if (!(flags & 1)) for (int st = blockIdx.x; st < 64; st += F.G) { scan_wg(F, st); __syncthreads(); }
        if (!(flags & 2)) zb_gemm(F.G, (int)blockIdx.x);
    }
}
DI void phase_combine(Frame& F, const float* gn  , int nrows) {
    const bf16* P = (const bf16*)(F.ws + WS_P); bf16* OZ = (bf16*)(F.ws + WS_OAZB);
    const bf16* OF = (const bf16*)(F.ws + WS_OF); const bf16* OB = (const bf16*)(F.ws + WS_OB);
    const int gw = blockIdx.x * NWAVES + F.wave, NGW = F.G * NWAVES;
    const int vl = (F.lane & 15) * 8;
    const f32x4 g0 = *(const f32x4*)(gn + vl), g1 = *(const f32x4*)(gn + vl + 4);
    for (int row = gw; row < nrows; row += NGW) {
#pragma unroll
        for (int it = 0; it < 4; ++it) { const int ch = (it * 4 + (F.lane >> 4)) * DK + vl;
            const size_t off = (size_t)row * WA + ch;
            const v4u of4 = *(const GAS v4u*)(OF + off), ob4 = *(const GAS v4u*)(OB + off);
            f32x4 a = {bflo(of4[0]) + bflo(ob4[0]), bfhi(of4[0]) + bfhi(ob4[0]), bflo(of4[1]) + bflo(ob4[1]), bfhi(of4[1]) + bfhi(ob4[1])}, b = {bflo(of4[2]) + bflo(ob4[2]), bfhi(of4[2]) + bfhi(ob4[2]), bflo(of4[3]) + bflo(ob4[3]), bfhi(of4[3]) + bfhi(ob4[3])};
            const v4u gw4 = *(const GAS v4u*)(P + (size_t)row * NIN + C_G + ch);
            float ss = (a[0] * a[0] + a[1] * a[1]) + (a[2] * a[2] + a[3] * a[3]) + (b[0] * b[0] + b[1] * b[1]) + (b[2] * b[2] + b[3] * b[3]);
            ss += shfl_x(ss, 1, F.lane); ss += shfl_x(ss, 2, F.lane); ss += shfl_x(ss, 4, F.lane); ss += shfl_x(ss, 8, F.lane);
            const float rinv = 1.f / sqrtf(ss * (1.f / DK) + RMS_EPS);
            float gl[8];
#pragma unroll
            for (int w = 0; w < 4; ++w) { const float x0 = bflo(gw4[w]), x1 = bfhi(gw4[w]); gl[2 * w] = x0 * sigmoidf_(x0); gl[2 * w + 1] = x1 * sigmoidf_(x1); }
            a = a * rinv * g0; b = b * rinv * g1;
            v4u o; o.x = pk2(a[0] * gl[0], a[1] * gl[1]); o.y = pk2(a[2] * gl[2], a[3] * gl[3]); o.z = pk2(b[0] * gl[4], b[1] * gl[5]); o.w = pk2(b[2] * gl[6], b[3] * gl[7]);
            *(GAS v4u*)(OZ + (size_t)row * D + ch) = o; }
    }
}
constexpr int N_PHASES = 3 + 2 * 10;
struct Args { const float* in[17]; float* out; unsigned char* ws; int ph_lo, ph_hi, flags, pad; };
__global__ void __launch_bounds__(NWAVES * 64, 2) mk_fwd(Args args) {
    extern __shared__ __attribute__((aligned(16))) unsigned char lds[];
    Frame F;
    F.lds = (LAS unsigned char*)lds;
    F.MISC = (volatile LAS unsigned*)(F.lds + MISC_OFF);
    F.tid = threadIdx.x; F.lane = F.tid & 63; F.wave = __builtin_amdgcn_readfirstlane(F.tid >> 6);
    F.G = gridDim.x; F.ws = args.ws;
    F.ctl = (gu32*)(args.ws + WS_CTL);
    for (int u = F.tid; u < (LDS_BYTES - LDSCTL_OFF) / 4; u += NWAVES * 64) ((LAS unsigned*)(F.lds + LDSCTL_OFF))[u] = 0u;
    __syncthreads();
#if MK_SPLIT
#define GRID_BAR() do { } while (0)
#else
    XcdBarrier bar = xcd_barrier_post((unsigned*)(F.ctl + CW_BAR), F.MISC + 8);
#define GRID_BAR() xcd_barrier(bar)
#endif
    unsigned char* ws = args.ws; const CAS Args* ap = nullptr;
#define MODP ((const float*)(ws + WS_MOD))
    const int lo = args.ph_lo, hi = args.ph_hi; (void)lo; (void)hi;
#ifndef PH_MASK
#define PH_MASK 0xffff
#endif
#define EN(kind) (((PH_MASK) >> (kind)) & 1)
#ifndef DUP_MASK
#define DUP_MASK 0
#endif
#define REPS(kind) (1 + (((DUP_MASK) >> (kind)) & 1))
#ifndef RT_RANGE
#define RT_RANGE 0
#define PROBE_LO 0
#define PROBE_HI 0
#define PROBE_FLAGS 0
#endif
#if MK_SPLIT || RT_RANGE
#define IN(k) (lo <= (k) && (k) < hi)
#else
#define IN(k) true
#endif
#define REFRESH() do { int t_; asm volatile("v_mbcnt_lo_u32_b32 %0, -1, 0\n\tv_mbcnt_hi_u32_b32 %0, -1, %0" : "=v"(t_)); t_ += F.wave * 64;     F.tid = t_; F.lane = t_ & 63; ap = (const CAS Args*)__builtin_amdgcn_kernarg_segment_ptr(); asm volatile("" : "+s"(ap)); ws = ap->ws; F.ws = ws; { unsigned lb_ = (unsigned)(size_t)(LAS unsigned char*)lds; asm volatile("" : "+s"(lb_)); F.lds = (LAS unsigned char*)(size_t)lb_; } } while (0)
#define INP(k) (ap->in[k])
#define SEAM(k) do { if (IN(k) && IN((k) + 1)) GRID_BAR(); } while (0)

    for (int rep_ = 0; rep_ < REPS(0); ++rep_) if (EN(0) && IN(0)) { if (rep_) GRID_BAR(); REFRESH(); P0Args A{INP(1), INP(3), INP(4), INP(6), INP(9), INP(10), INP(11), INP(12), INP(13)}; phase0(F, A); } SEAM(0);
    for (int rep_ = 0; rep_ < REPS(1); ++rep_) if (EN(1) && IN(1)) { if (rep_) GRID_BAR(); REFRESH(); phase1(F, INP(5)); } SEAM(1);
#ifdef PROBE_EXTRA_BARRIERS
    for (int xb_ = 0; xb_ < PROBE_EXTRA_BARRIERS; ++xb_) GRID_BAR();
#endif
    for (int rep_ = 0; rep_ < REPS(2); ++rep_) if (EN(2) && IN(2)) { if (rep_) GRID_BAR(); REFRESH(); phase_modulate0(F, INP(0), INP(2)); } SEAM(2);

    for (int l = 0; l < 2; ++l) {
        const int pb = 3 + 10 * l;
        const bool last = (l == 1);
        const int Mrows = last ? ML : MR;
#define MODL (MODP + (size_t)l * 3 * NIN)
        for (int rep_ = 0; rep_ < REPS(3); ++rep_) if (EN(3) && IN(pb + 0)) { if (rep_) GRID_BAR(); REFRESH();
            pg8::Gemm g{(const pg8::bf16_t*)(ws + WS_U), (const pg8::bf16_t*)(ws + WS_WIN + l * SZ_WIN), MR, NIN, D, D}; pg8::StaticOrder S; S.init(MR, NIN, F.G, (int)blockIdx.x);
            pg8::EpiStoreBf16<0> E{(pg8::bf16_t*)(ws + WS_P), NIN, 0};
            pg8::gemm_phase<pg8::EpiStoreBf16<0>, pg8::StaticOrder, true, true>(F.lds + RING_OFF, g, S, E, F.tid);
            if (F.G == 256 && !(ap->flags & 32)) { P0Args A{INP(1), INP(3), INP(4), INP(6), INP(9), INP(10), INP(11), INP(12), INP(13)}; bg_convert(F, A, 192, l == 0 ? BG_S0 : BG_S4, l == 0 ? BG_S1 : BG_S5); }
        } SEAM(pb + 0);
        for (int rep_ = 0; rep_ < REPS(4); ++rep_) if (EN(4) && IN(pb + 1)) { if (rep_) GRID_BAR(); REFRESH(); phase_prep(F, INP(16), l, INP(7) + (size_t)l * 3 * WA, ap->flags); } SEAM(pb + 1);
        for (int rep_ = 0; rep_ < REPS(5); ++rep_) if (EN(5) && IN(pb + 2)) { if (rep_) GRID_BAR(); REFRESH();
            const int fl = ap->flags;
            auto zb_gemm = [&](int G2, int c2) {
                pg8::Gemm g{(const pg8::bf16_t*)(ws + WS_OAZB), (const pg8::bf16_t*)(ws + WS_WAB + l * SZ_WAB), Mrows, D, D, D / 2}; pg8::StaticOrder S; S.init(Mrows, D, G2, c2); S.kc0 = 1;
                pg8::EpiPartB E{(const pg8::bf16_t*)(ws + WS_P), (pg8::bf16_t*)(ws + WS_YPART)};
                pg8::gemm_phase<pg8::EpiPartB, pg8::StaticOrder, true, true>(F.lds + RING_OFF, g, S, E, F.tid); };
            phase_scan_gemm(F, fl, zb_gemm);
        } SEAM(pb + 2);
        for (int rep_ = 0; rep_ < REPS(6); ++rep_) if (EN(6) && IN(pb + 3)) { if (rep_) GRID_BAR(); REFRESH(); phase_combine(F, INP(8) + l * DK, Mrows); } SEAM(pb + 3);
        for (int rep_ = 0; rep_ < REPS(7); ++rep_) if (EN(7) && IN(pb + 4)) { if (rep_) GRID_BAR(); REFRESH();
            pg8::Gemm g{(const pg8::bf16_t*)(ws + WS_OAZB), (const pg8::bf16_t*)(ws + WS_WAB + l * SZ_WAB), Mrows, D, D, D / 2}; pg8::StaticOrder S; S.init(Mrows, D, F.G, (int)blockIdx.x);
            pg8::EpiMergeA E{(const pg8::bf16_t*)(ws + WS_P), (const pg8::bf16_t*)(ws + WS_YPART), (pg8::bf16_t*)(ws + WS_YPRE)};
            pg8::gemm_phase<pg8::EpiMergeA, pg8::StaticOrder, true, true>(F.lds + RING_OFF, g, S, E, F.tid);
            if (F.G == 256 && l == 0 && !(ap->flags & 32)) { P0Args A{INP(1), INP(3), INP(4), INP(6), INP(9), INP(10), INP(11), INP(12), INP(13)}; bg_convert(F, A, 32, BG_S2, BG_S3); }
        } SEAM(pb + 4);
        for (int rep_ = 0; rep_ < REPS(8); ++rep_) if (EN(8) && IN(pb + 5)) { if (rep_) GRID_BAR(); REFRESH();
            { pg8::Gemm g{(const pg8::bf16_t*)(ws + WS_YPRE), (const pg8::bf16_t*)(ws + WS_WO + l * SZ_WO), ML, D, D, D}; pg8::StaticOrder S; S.init(ML, D, F.G, (int)blockIdx.x);
              if (l == 0) { const float* xl = INP(0); pg8::EpiRes E{xl, xl, MODL, 2 * D, (float*)(ws + WS_R), ALPHA};
                  pg8::gemm_phase<pg8::EpiRes, pg8::StaticOrder, true, true>(F.lds + RING_OFF, g, S, E, F.tid); }
              else {
                  pg8::EpiResLn E{(const float*)(ws + WS_ST) + 2 * MR, INP(14) + (size_t)1 * D, INP(15) + (size_t)1 * D, MODL, 2 * D, (float*)(ws + WS_R), ALPHA};
                  pg8::gemm_phase<pg8::EpiResLn, pg8::StaticOrder, true, true>(F.lds + RING_OFF, g, S, E, F.tid); } }
            if (!last) { pg8::Gemm g{(const pg8::bf16_t*)(ws + WS_YPRE) + (size_t)ML * D, (const pg8::bf16_t*)(ws + WS_WO + l * SZ_WO), MC, D, D, D / 8}; pg8::SplitOrder S; S.init(F.G, (int)blockIdx.x);
              pg8::EpiSlab E{(float*)(ws + WS_SLAB), (ap->flags & 512) ? 1 : 0};
              pg8::gemm_phase<pg8::EpiSlab, pg8::SplitOrder, true, true>(F.lds + RING_OFF, g, S, E, F.tid); }
        } SEAM(pb + 5);
        for (int rep_ = 0; rep_ < REPS(9); ++rep_) if (EN(9) && IN(pb + 6)) { if (rep_) GRID_BAR(); REFRESH();
            if (!last) phase_ln<true, true>(F, (const float*)(ws + WS_R), INP(14) + (size_t)(l * 2 + 0) * D, INP(15) + (size_t)(l * 2 + 0) * D, (float*)(ws + WS_X1), ML  , (float*)(ws + WS_ST), MR, MODL, 3 * D, 4 * D, (const float*)(ws + WS_SLAB), INP(2), MODL + 2 * NIN + 2 * D);
            else phase_ln<true, false>(F, (const float*)(ws + WS_R), INP(14) + (size_t)(l * 2 + 0) * D, INP(15) + (size_t)(l * 2 + 0) * D, (float*)(ws + WS_X1), 0x7fffffff, (float*)(ws + WS_ST), ML, MODL, 3 * D, 4 * D, nullptr, nullptr, nullptr);
        } SEAM(pb + 6);
        for (int rep_ = 0; rep_ < REPS(10); ++rep_) if (EN(10) && IN(pb + 7)) { if (rep_) GRID_BAR(); REFRESH();
            pg8::Gemm g{(const pg8::bf16_t*)(ws + WS_U), (const pg8::bf16_t*)(ws + WS_WUP + l * SZ_WUP), Mrows, DFF, D, (ap->flags & 16) ? D / 4 : D}; pg8::StaticOrder S; S.init(Mrows, DFF, F.G, (int)blockIdx.x); if (ap->flags & 4) S.bmask = 0; if (ap->flags & 8) S.amask = 0;
            if (ap->flags & 128) { S.init(Mrows, DFF, F.G / 2, (int)blockIdx.x >> 1); if (blockIdx.x & 1) S.nwg = 0; }
            pg8::EpiStoreBf16<1> E{(pg8::bf16_t*)(ws + WS_H), DFF, (ap->flags & 64) ? 1 : 0};
            pg8::gemm_phase<pg8::EpiStoreBf16<1>, pg8::StaticOrder, true, true>(F.lds + RING_OFF, g, S, E, F.tid);
            if (F.G == 256 && l == 0 && !(ap->flags & 32)) { P0Args A{INP(1), INP(3), INP(4), INP(6), INP(9), INP(10), INP(11), INP(12), INP(13)}; bg_convert(F, A, 128, BG_S3, BG_S4); }
        } SEAM(pb + 7);
        for (int rep_ = 0; rep_ < REPS(11); ++rep_) if (EN(11) && IN(pb + 8)) { if (rep_) GRID_BAR(); REFRESH();
            { pg8::Gemm g{(const pg8::bf16_t*)(ws + WS_H), (const pg8::bf16_t*)(ws + WS_WDN + l * SZ_WDN), ML, D, DFF, DFF}; pg8::StaticOrder S; S.init(ML, D, F.G, (int)blockIdx.x);
              pg8::EpiResLn E{(const float*)(ws + WS_ST), INP(14) + (size_t)(l * 2 + 0) * D, INP(15) + (size_t)(l * 2 + 0) * D, MODL, 5 * D, (float*)(ws + WS_R), ALPHA};
              pg8::gemm_phase<pg8::EpiResLn, pg8::StaticOrder, true, true>(F.lds + RING_OFF, g, S, E, F.tid); }
            if (!last && !(ap->flags & 256)) { pg8::Gemm g{(const pg8::bf16_t*)(ws + WS_H) + (size_t)ML * DFF, (const pg8::bf16_t*)(ws + WS_WDN + l * SZ_WDN), MC, D, DFF, DFF / 8}; pg8::SplitOrder S; S.init(F.G, (int)blockIdx.x);
              pg8::EpiSlab E{(float*)(ws + WS_SLAB), (ap->flags & 512) ? 1 : 0};
              pg8::gemm_phase<pg8::EpiSlab, pg8::SplitOrder, true, true>(F.lds + RING_OFF, g, S, E, F.tid); }
        } SEAM(pb + 8);
        for (int rep_ = 0; rep_ < REPS(12); ++rep_) if (EN(12) && IN(pb + 9)) { if (rep_) GRID_BAR(); REFRESH();
            if (!last) phase_ln<true, true>(F, (const float*)(ws + WS_R), INP(14) + (size_t)(l * 2 + 1) * D, INP(15) + (size_t)(l * 2 + 1) * D, (float*)(ws + WS_X2), 0x7fffffff  , (float*)(ws + WS_ST) + 2 * MR, MR, MODP + (size_t)(l + 1) * 3 * NIN, 0, D, (const float*)(ws + WS_SLAB), (const float*)(ws + WS_X1) + (size_t)ML * D, MODL + 2 * NIN + 5 * D);
            else phase_ln<false, false>(F, (const float*)(ws + WS_R), INP(14) + (size_t)(l * 2 + 1) * D, INP(15) + (size_t)(l * 2 + 1) * D, ap->out, 0, nullptr, ML, nullptr, 0, 0, nullptr, nullptr, nullptr);
        }
        if (!last) SEAM(pb + 9);
    }
#undef IN
#undef SEAM
}

extern "C" void kernel_launch(void* const* d_in, const int* in_sizes, int n_in, void* d_out, int out_size, void* d_ws, size_t ws_size, hipStream_t stream) {
    static int grid = 0;
    if (grid == 0) {
        if (n_in != 17 || in_sizes[0] != ML * D || out_size != ML * D || ws_size < WS_END) {
            fprintf(stderr, "kernel_launch: unexpected shapes (n_in %d, in0 %d, out %d, ws %zu < %zu); nothing launched\n", n_in, n_in > 0 ? in_sizes[0] : -1, out_size, ws_size, (size_t)WS_END); grid = -1; return; }
        int dev = 0, cus = 0, per_cu = 0;
        if (hipGetDevice(&dev) != hipSuccess || hipDeviceGetAttribute(&cus, hipDeviceAttributeMultiprocessorCount, dev) != hipSuccess) { fprintf(stderr, "kernel_launch: device query failed\n"); grid = -1; return; }
        if (hipFuncSetAttribute((const void*)mk_fwd, hipFuncAttributeMaxDynamicSharedMemorySize, LDS_BYTES) != hipSuccess) { fprintf(stderr, "kernel_launch: hipFuncSetAttribute failed\n"); grid = -1; return; }
        if (hipOccupancyMaxActiveBlocksPerMultiprocessor(&per_cu, (const void*)mk_fwd, NWAVES * 64, LDS_BYTES) != hipSuccess || per_cu < 1)
            fprintf(stderr, "kernel_launch: note: occupancy query reports %d workgroups per CU\n", per_cu);
        (void)hipGetLastError();
        grid = cus;
    }
    if (grid < 0) return;
    if (hipMemsetAsync((char*)d_ws + WS_CTL, 0, CTL_ZERO_BYTES, stream) != hipSuccess) { fprintf(stderr, "kernel_launch: memset failed\n"); return; }
    Args a{};
    for (int i = 0; i < 17; ++i) a.in[i] = (const float*)d_in[i];
    a.out = (float*)d_out; a.ws = (unsigned char*)d_ws;
#if MK_SPLIT
    for (int ph = 0; ph < N_PHASES; ++ph) { a.ph_lo = ph; a.ph_hi = ph + 1; hipLaunchKernelGGL(mk_fwd, dim3(grid), dim3(NWAVES * 64), LDS_BYTES, stream, a); }
#else
    a.ph_lo = 0; a.ph_hi = N_PHASES;
    hipLaunchKernelGGL(mk_fwd, dim3(grid), dim3(NWAVES * 64), LDS_BYTES, stream, a);
#if RT_RANGE
    for (int l = 0; l < 2; ++l) { (void)hipMemsetAsync((char*)d_ws + WS_CTL, 0, CTL_ZERO_BYTES, stream); a.ph_lo = 3 + 10 * l + PROBE_LO; a.ph_hi = 3 + 10 * l + PROBE_HI; a.flags = PROBE_FLAGS; hipLaunchKernelGGL(mk_fwd, dim3(grid), dim3(NWAVES * 64), LDS_BYTES, stream, a); }
#endif
#endif
    const hipError_t le = hipPeekAtLastError();
    if (le != hipSuccess) fprintf(stderr, "kernel_launch: launch failed: %s\n", hipGetErrorName(le));
}
```

```cpp
#include <hip/hip_runtime.h>
#include <cstdio>
#include <cstdint>

#ifndef MK_SPLIT
#define MK_SPLIT 0
#endif

namespace pg8 {
#define PG8_LAS __attribute__((address_space(3)))
typedef unsigned short bf16_t;
typedef short bf16x8 __attribute__((ext_vector_type(8)));
typedef float f32x4 __attribute__((ext_vector_type(4)));
typedef unsigned u32x4 __attribute__((ext_vector_type(4)));
constexpr int BM = 256, BK = 64, HALF = 128, HTB = HALF * BK * 2  , STAGE_BYTES = 8 * HTB, NXCD = 8, WGM = 8;

__host__ __device__ __forceinline__ int lds_byte(int r, int c) { const int st = (r >> 4) * 2 + (c >> 5), rr = r & 15, cc = c & 31, ob = rr * 64 + cc * 2; return st * 1024 + (ob ^ (((ob >> 9) & 1) << 5)); }
__host__ __device__ __forceinline__ void stage_rc(int b, int& R, int& C) { const int st = b / 1024, sb = b % 1024, swz = sb ^ (((sb >> 9) & 1) << 5); R = (st >> 1) * 16 + swz / 64; C = (st & 1) * 32 + (swz % 64) / 2; }
__host__ __device__ __forceinline__ int perm32(int rho) { const int n = rho >> 4, i = rho & 15; return 8 * (i >> 2) + 4 * n + (i & 3); }

struct Unit { int pm, pn, kc, am, bn; };
struct Gemm { const bf16_t* A; const bf16_t* Bt; int M, N, K, Kc; };

struct StaticOrder {
    int nM, nN, nwg, G, c, amask = -1, bmask = -1, kc0 = 0;
    __host__ __device__ void init(int M, int N, int G_, int c_) { nM = M / BM; nN = N / BM; nwg = nM * nN; G = G_; c = c_; }
    __host__ __device__ bool next(int i, Unit& u) const {
        const long L = (long)i * G + c; if (L >= nwg) return false;
        int wgid = (int)L; { const int q = nwg / NXCD, r = nwg % NXCD, xcd = wgid % NXCD, off = wgid / NXCD; wgid = (xcd < r ? xcd * (q + 1) : r * (q + 1) + (xcd - r) * q) + off; }
        const int nig = WGM * nM, gid = wgid / nig, fn = gid * WGM, gsz = (nN - fn) < WGM ? (nN - fn) : WGM;
        u.pn = fn + ((wgid % nig) % gsz); u.pm = (wgid % nig) / gsz; u.kc = kc0; u.am = u.pm & amask; u.bn = u.pn & bmask; return true;
    }
    __device__ __forceinline__ void a_ready(const Unit&) const {}
    __device__ __forceinline__ void done(const Unit&) const {}
};

__device__ __forceinline__ unsigned cvt_pk_bf16(float lo, float hi) { unsigned r; asm volatile("v_cvt_pk_bf16_f32 %0, %1, %2" : "=v"(r) : "v"(lo), "v"(hi)); return r; }
__device__ __forceinline__ float bf_lo(unsigned w) { return __uint_as_float(w << 16); }
__device__ __forceinline__ float bf_hi(unsigned w) { return __uint_as_float(w & 0xffff0000u); }

struct SplitOrder {
    int G, c;
    __host__ __device__ void init(int G_, int c_) { G = G_; c = c_; }
    __host__ __device__ bool next(int i, Unit& u) const { const int L = i * G + c; if (L >= 256) return false; u.kc = L & 7; const int t = L >> 3; u.pm = t & 1; u.pn = t >> 1; u.am = u.pm; u.bn = u.pn; return true; }
    __device__ __forceinline__ void a_ready(const Unit&) const {}
    __device__ __forceinline__ void done(const Unit&) const {}
};

template <int ACT  > struct EpiStoreBf16 {
    static constexpr bool PERM = true, AFTER_DRAIN = false, HAS_MID = false;
    bf16_t* O; int ldc; int skip;
    __device__ __forceinline__ void mid(f32x4 (&)[2][2][4][2], const Unit&, int, int, int, int) const {}
    __device__ __forceinline__ void operator()(f32x4 (&acc)[2][2][4][2], const Unit& u, int wr, int wc, int fr, int fq) const {
        if (skip) return;
        const int row0 = u.pm * BM + wr * 64 + fr, col0 = u.pn * BM + wc * 32 + 8 * fq;
#pragma unroll
        for (int ai = 0; ai < 2; ++ai)
#pragma unroll
            for (int m = 0; m < 4; ++m) { bf16_t* rowp = O + (size_t)(row0 + ai * HALF + m * 16) * ldc + col0;
#pragma unroll
                for (int bj = 0; bj < 2; ++bj) { f32x4 v0 = acc[ai][bj][m][0], v1 = acc[ai][bj][m][1];
                    if (ACT == 1) {
#pragma unroll
                        for (int j = 0; j < 4; ++j) { const float a = fmaxf(v0[j], 0.f), b = fmaxf(v1[j], 0.f); v0[j] = a * a; v1[j] = b * b; } }
                    u32x4 w; w.x = cvt_pk_bf16(v0[0], v0[1]); w.y = cvt_pk_bf16(v0[2], v0[3]); w.z = cvt_pk_bf16(v1[0], v1[1]); w.w = cvt_pk_bf16(v1[2], v1[3]);
                    *(u32x4*)(rowp + bj * HALF) = w; } }
    }
};
struct EpiRes {
    static constexpr bool PERM = false, AFTER_DRAIN = false, HAS_MID = false;
    const float* xlat; const float* xctx; const float* modl; int which; float* R; float alpha;
    __device__ __forceinline__ void mid(f32x4 (&)[2][2][4][2], const Unit&, int, int, int, int) const {}
    __device__ __forceinline__ void operator()(f32x4 (&acc)[2][2][4][2], const Unit& u, int wr, int wc, int fr, int fq) const {
        const int rl0 = wr * 64 + fr, col0 = u.pn * BM + wc * 32 + 4 * fq;
        const int vec = u.pm < 16 ? 0 : (u.pm < 32 ? 1 : 2);
        const float* g = modl + vec * 24576 + which + col0;
        const float* xb = (u.pm < 32 ? xlat + (size_t)u.pm * BM * 4096 : xctx + (size_t)(u.pm - 32) * BM * 4096) + col0;
        float* rb = R + (size_t)u.pm * BM * 4096 + col0;
        f32x4 gv[2][2];
#pragma unroll
        for (int bj = 0; bj < 2; ++bj)
#pragma unroll
            for (int n = 0; n < 2; ++n) gv[bj][n] = *(const f32x4*)(g + bj * HALF + n * 16);
#pragma unroll
        for (int ai = 0; ai < 2; ++ai)
#pragma unroll
            for (int m = 0; m < 4; ++m) { const size_t ro = (size_t)(rl0 + ai * HALF + m * 16) * 4096;
#pragma unroll
                for (int bj = 0; bj < 2; ++bj)
#pragma unroll
                    for (int n = 0; n < 2; ++n) { const f32x4 xs = *(const f32x4*)(xb + ro + bj * HALF + n * 16);
                        *(f32x4*)(rb + ro + bj * HALF + n * 16) = xs * alpha + gv[bj][n] * acc[ai][bj][m][n]; }
                asm volatile("" ::: "memory"); }
    }
};
struct EpiResLn {
    static constexpr bool PERM = false, AFTER_DRAIN = false, HAS_MID = false;
    const float* st; const float* lng; const float* lnb; const float* modl; int which; float* R; float alpha;
    __device__ __forceinline__ void mid(f32x4 (&)[2][2][4][2], const Unit&, int, int, int, int) const {}
    __device__ __forceinline__ void operator()(f32x4 (&acc)[2][2][4][2], const Unit& u, int wr, int wc, int fr, int fq) const {
        const int rl0 = wr * 64 + fr, col0 = u.pn * BM + wc * 32 + 4 * fq;
        const int vec = u.pm < 16 ? 0 : 1;
        const float* g = modl + vec * 24576 + which + col0;
        float* rb = R + (size_t)u.pm * BM * 4096 + col0;
        f32x4 gv[2][2];
        const float* sp = st + (size_t)(u.pm * BM + rl0) * 2;
#pragma unroll
        for (int bj = 0; bj < 2; ++bj)
#pragma unroll
            for (int n = 0; n < 2; ++n) gv[bj][n] = *(const f32x4*)(g + bj * HALF + n * 16);
#pragma unroll
        for (int ai = 0; ai < 2; ++ai)
#pragma unroll
            for (int m = 0; m < 4; ++m) { const size_t ro = (size_t)(rl0 + ai * HALF + m * 16) * 4096;
                const float mean = sp[(ai * HALF + m * 16) * 2], rs = sp[(ai * HALF + m * 16) * 2 + 1] * alpha;
                int c = col0; asm volatile("" : "+v"(c));
#pragma unroll
                for (int bj = 0; bj < 2; ++bj)
#pragma unroll
                    for (int n = 0; n < 2; ++n) { const f32x4 ro_ = *(const f32x4*)(rb + ro + bj * HALF + n * 16);
                        const f32x4 la = *(const f32x4*)(lng + c + bj * HALF + n * 16), lb = *(const f32x4*)(lnb + c + bj * HALF + n * 16);
                        *(f32x4*)(rb + ro + bj * HALF + n * 16) = (ro_ - mean) * rs * la + lb * alpha + gv[bj][n] * acc[ai][bj][m][n]; }
                asm volatile("" ::: "memory"); }
    }
};
struct EpiSlab {
    static constexpr bool PERM = false, AFTER_DRAIN = false, HAS_MID = false;
    float* slab; int skip;
    __device__ __forceinline__ void mid(f32x4 (&)[2][2][4][2], const Unit&, int, int, int, int) const {}
    __device__ __forceinline__ void operator()(f32x4 (&acc)[2][2][4][2], const Unit& u, int wr, int wc, int fr, int fq) const {
        if (skip) return;
        float* rb = slab + ((size_t)u.kc * 512 + (size_t)u.pm * BM + wr * 64 + fr) * 4096 + u.pn * BM + wc * 32 + 4 * fq;
#pragma unroll
        for (int ai = 0; ai < 2; ++ai)
#pragma unroll
            for (int m = 0; m < 4; ++m)
#pragma unroll
                for (int bj = 0; bj < 2; ++bj)
#pragma unroll
                    for (int n = 0; n < 2; ++n) *(f32x4*)(rb + (size_t)(ai * HALF + m * 16) * 4096 + bj * HALF + n * 16) = acc[ai][bj][m][n];
    }
};
struct EpiPartB {
    static constexpr bool PERM = true, AFTER_DRAIN = false, HAS_MID = false;
    const bf16_t* P; bf16_t* YP;
    __device__ __forceinline__ void mid(f32x4 (&)[2][2][4][2], const Unit&, int, int, int, int) const {}
    __device__ __forceinline__ void operator()(f32x4 (&acc)[2][2][4][2], const Unit& u, int wr, int wc, int fr, int fq) const {
        const int row0 = u.pm * BM + wr * 64 + fr, col0 = u.pn * BM + wc * 32 + 8 * fq;
#pragma unroll
        for (int ai = 0; ai < 2; ++ai)
#pragma unroll
            for (int m = 0; m < 4; ++m) { const size_t row = (size_t)(row0 + ai * HALF + m * 16);
#pragma unroll
                for (int bj = 0; bj < 2; ++bj) { const u32x4 gb = *(const u32x4*)(P + row * 24576 + 20480 + col0 + bj * HALF);
                    float o[8];
#pragma unroll
                    for (int w = 0; w < 4; ++w) {
                        const float s0 = __builtin_amdgcn_rcpf(1.f + __builtin_amdgcn_exp2f(-1.44269504f * bf_lo(gb[w]))), s1 = __builtin_amdgcn_rcpf(1.f + __builtin_amdgcn_exp2f(-1.44269504f * bf_hi(gb[w])));
                        o[2 * w] = acc[ai][bj][m][w >> 1][(w & 1) * 2] * s0; o[2 * w + 1] = acc[ai][bj][m][w >> 1][(w & 1) * 2 + 1] * s1; }
                    u32x4 wv; wv.x = cvt_pk_bf16(o[0], o[1]); wv.y = cvt_pk_bf16(o[2], o[3]); wv.z = cvt_pk_bf16(o[4], o[5]); wv.w = cvt_pk_bf16(o[6], o[7]);
                    *(u32x4*)(YP + row * 4096 + col0 + bj * HALF) = wv; }
                asm volatile("" ::: "memory"); }
    }
};
struct EpiMergeA {
    static constexpr bool PERM = true, AFTER_DRAIN = false, HAS_MID = false;
    const bf16_t* P; const bf16_t* YP; bf16_t* Y;
    __device__ __forceinline__ void mid(f32x4 (&)[2][2][4][2], const Unit&, int, int, int, int) const {}
    __device__ __forceinline__ void operator()(f32x4 (&acc)[2][2][4][2], const Unit& u, int wr, int wc, int fr, int fq) const {
        const int row0 = u.pm * BM + wr * 64 + fr, col0 = u.pn * BM + wc * 32 + 8 * fq;
#pragma unroll
        for (int ai = 0; ai < 2; ++ai)
#pragma unroll
            for (int m = 0; m < 4; ++m) { const size_t row = (size_t)(row0 + ai * HALF + m * 16);
#pragma unroll
                for (int bj = 0; bj < 2; ++bj) { const u32x4 ga = *(const u32x4*)(P + row * 24576 + 16384 + col0 + bj * HALF), yp = *(const u32x4*)(YP + row * 4096 + col0 + bj * HALF);
                    float o[8];
#pragma unroll
                    for (int w = 0; w < 4; ++w) {
                        const float s0 = __builtin_amdgcn_rcpf(1.f + __builtin_amdgcn_exp2f(-1.44269504f * bf_lo(ga[w]))), s1 = __builtin_amdgcn_rcpf(1.f + __builtin_amdgcn_exp2f(-1.44269504f * bf_hi(ga[w])));
                        o[2 * w] = acc[ai][bj][m][w >> 1][(w & 1) * 2] * s0 + bf_lo(yp[w]); o[2 * w + 1] = acc[ai][bj][m][w >> 1][(w & 1) * 2 + 1] * s1 + bf_hi(yp[w]); }
                    u32x4 wv; wv.x = cvt_pk_bf16(o[0], o[1]); wv.y = cvt_pk_bf16(o[2], o[3]); wv.z = cvt_pk_bf16(o[4], o[5]); wv.w = cvt_pk_bf16(o[6], o[7]);
                    *(u32x4*)(Y + row * 4096 + col0 + bj * HALF) = wv; }
                asm volatile("" ::: "memory"); }
    }
};

template <class Epi, class Sched, bool ALIGN_EPI = false, bool SP2 = false>
__device__ __forceinline__ void gemm_phase(PG8_LAS unsigned char* lds, const Gemm g, const Sched& S, const Epi& E, const int tid) {
    const int wid = __builtin_amdgcn_readfirstlane(tid >> 6), lane = tid & 63, wr = wid >> 2, wc = wid & 3, fr = lane & 15, fq = lane >> 4;
    const int K = g.K, nt = g.Kc / BK;
    unsigned voffA[2], voffB[2];
#pragma unroll
    for (int i = 0; i < 2; ++i) { int R, C; stage_rc(tid * 16 + i * 8192, R, C); const int Rb = Epi::PERM ? ((R & ~31) + perm32(R & 31)) : R;
        voffA[i] = (unsigned)(R * K + C) * 2u; voffB[i] = (unsigned)(Rb * BK + C) * 2u; }
    const size_t kstep = (size_t)(BK * 2);
    const size_t hstep = (size_t)HALF * K * 2;
    const size_t tstep = 2 * hstep;
    const size_t kstepB = (size_t)BM * BK * 2, hstepB = (size_t)HALF * BK * 2;
    const unsigned ldsw = (unsigned)wid * 1024u;
    const int aoff = lds_byte(wr * 64 + fr, fq * 8), boff = lds_byte(wc * 32 + fr, fq * 8);
#define PG8_SA(b, h) (((b) * 2 + (h)) * HTB)
#define PG8_SB(b, h) ((4 + (b) * 2 + (h)) * HTB)
#define PG8_STAGE(bufoff, gbase, voff) do { _Pragma("unroll") for (int _i = 0; _i < 2; ++_i) \
        __builtin_amdgcn_global_load_lds((const unsigned*)((const char*)(gbase) + (voff)[_i]), (PG8_LAS unsigned*)(lds + (bufoff) + ldsw + _i * 8192), 16, 0, 0); } while (0)
#define PG8_LDA(dst, b, h) do { _Pragma("unroll") for (int m = 0; m < 4; ++m) _Pragma("unroll") for (int k = 0; k < 2; ++k) dst[m][k] = *(const PG8_LAS bf16x8*)(lds + PG8_SA(b, h) + aoff + m * 2048 + k * 1024); } while (0)
#define PG8_LDB(dst, b, h) do { _Pragma("unroll") for (int n = 0; n < 2; ++n) _Pragma("unroll") for (int k = 0; k < 2; ++k) dst[n][k] = *(const PG8_LAS bf16x8*)(lds + PG8_SB(b, h) + boff + n * 2048 + k * 1024); } while (0)
#define PG8_MMA(ai, bj, At, Bt) do { __builtin_amdgcn_s_setprio(1); _Pragma("unroll") for (int m = 0; m < 4; ++m) _Pragma("unroll") for (int n = 0; n < 2; ++n) _Pragma("unroll") for (int k = 0; k < 2; ++k) \
        acc[ai][bj][m][n] = __builtin_amdgcn_mfma_f32_16x16x32_bf16(Bt[n][k], At[m][k], acc[ai][bj][m][n], 0, 0, 0); __builtin_amdgcn_s_setprio(0); } while (0)
#define PG8_WAIT_V(n) asm volatile("s_waitcnt vmcnt(" #n ")" ::: "memory")
#define PG8_WAIT_L(n) asm volatile("s_waitcnt lgkmcnt(" #n ")" ::: "memory")
#define PG8_BAR __builtin_amdgcn_s_barrier()
#define PG8_SCHED __builtin_amdgcn_sched_barrier(0)
    Unit cur, nxt; int ui = 0;
    if (!S.next(0, cur)) return;
    f32x4 acc[2][2][4][2];
#pragma unroll
    for (int a = 0; a < 2; ++a)
#pragma unroll
        for (int b = 0; b < 2; ++b)
#pragma unroll
            for (int m = 0; m < 4; ++m)
#pragma unroll
                for (int n = 0; n < 2; ++n) acc[a][b][m][n] = (f32x4){0.f, 0.f, 0.f, 0.f};
    bf16x8 At[4][2], B0[2][2], B1[2][2];
    const size_t cstep = (size_t)g.Kc * 2, cstepB = (size_t)(g.Kc / BK) * kstepB;
    const char* cA = (const char*)g.A + (size_t)cur.am * tstep + (size_t)cur.kc * cstep; const char* cB = (const char*)g.Bt + (size_t)cur.bn * tstep + (size_t)cur.kc * cstepB;
    S.a_ready(cur);
    if constexpr (SP2) {
        PG8_STAGE(PG8_SB(0, 0), cB, voffB); PG8_STAGE(PG8_SB(0, 1), cB + hstepB, voffB); PG8_STAGE(PG8_SA(0, 0), cA, voffA); PG8_STAGE(PG8_SA(0, 1), cA + hstep, voffA);
        if (wr == 1) PG8_BAR;
        PG8_WAIT_V(2); PG8_BAR;
        PG8_STAGE(PG8_SB(1, 0), cB + kstepB, voffB); PG8_STAGE(PG8_SA(1, 0), cA + kstep, voffA); PG8_STAGE(PG8_SB(1, 1), cB + hstepB + kstepB, voffB);
        PG8_WAIT_V(6); PG8_BAR;
    } else {
        PG8_STAGE(PG8_SB(0, 0), cB, voffB); PG8_STAGE(PG8_SA(0, 0), cA, voffA); PG8_STAGE(PG8_SB(0, 1), cB + hstepB, voffB); PG8_STAGE(PG8_SA(0, 1), cA + hstep, voffA);
        if (wr == 1) PG8_BAR;
        PG8_WAIT_V(4); PG8_BAR;
        PG8_STAGE(PG8_SB(1, 0), cB + kstepB, voffB); PG8_STAGE(PG8_SA(1, 0), cA + kstep, voffA); PG8_STAGE(PG8_SB(1, 1), cB + hstepB + kstepB, voffB);
        PG8_WAIT_V(6); PG8_BAR;
    }
    for (;;) {
        const bool has_next = S.next(ui + 1, nxt);
        const char* nA = has_next ? (const char*)g.A + (size_t)nxt.am * tstep + (size_t)nxt.kc * cstep : cA; const char* nB = has_next ? (const char*)g.Bt + (size_t)nxt.bn * tstep + (size_t)nxt.kc * cstepB : cB;
        for (int t = 0; t < nt; t += 2) {
            const bool last = (t == nt - 2);
            const char* a1 = cA + (size_t)(t + 1) * kstep;
            const char* a2 = last ? nA : cA + (size_t)(t + 2) * kstep; const char* b2 = last ? nB : cB + (size_t)(t + 2) * kstepB;
            const char* a3 = a2 + kstep; const char* b3 = b2 + kstepB;
            if (last && has_next) S.a_ready(nxt);
            if constexpr (Epi::HAS_MID) { if (t == (nt >> 1)) E.mid(acc, cur, wr, wc, fr, fq); }
            if constexpr (SP2) {
            PG8_LDB(B0, 0, 0); PG8_LDB(B1, 0, 1); PG8_SCHED; PG8_LDA(At, 0, 0); PG8_STAGE(PG8_SA(1, 1), a1 + hstep, voffA);
            PG8_WAIT_V(8); PG8_WAIT_L(0); PG8_BAR; PG8_MMA(0, 0, At, B0); PG8_MMA(0, 1, At, B1); PG8_BAR; PG8_SCHED;
            PG8_LDA(At, 0, 1); PG8_STAGE(PG8_SB(0, 0), b2, voffB); PG8_STAGE(PG8_SB(0, 1), b2 + hstepB, voffB); PG8_STAGE(PG8_SA(0, 0), a2, voffA);
            PG8_WAIT_V(8); PG8_WAIT_L(0); PG8_BAR; PG8_MMA(1, 0, At, B0); PG8_MMA(1, 1, At, B1); PG8_BAR; PG8_SCHED;
            PG8_LDB(B0, 1, 0); PG8_LDB(B1, 1, 1); PG8_SCHED; PG8_LDA(At, 1, 0); PG8_STAGE(PG8_SA(0, 1), a2 + hstep, voffA);
            PG8_WAIT_V(8); PG8_WAIT_L(0); PG8_BAR; PG8_MMA(0, 0, At, B0); PG8_MMA(0, 1, At, B1); PG8_BAR; PG8_SCHED;
            PG8_LDA(At, 1, 1); PG8_STAGE(PG8_SB(1, 0), b3, voffB); PG8_STAGE(PG8_SB(1, 1), b3 + hstepB, voffB); PG8_STAGE(PG8_SA(1, 0), a3, voffA);
            PG8_WAIT_V(8); PG8_WAIT_L(0); PG8_BAR; PG8_MMA(1, 0, At, B0); PG8_MMA(1, 1, At, B1); PG8_BAR; PG8_SCHED;
            } else {
            PG8_LDB(B0, 0, 0); PG8_SCHED; PG8_LDA(At, 0, 0); PG8_STAGE(PG8_SA(1, 1), a1 + hstep, voffA);
            PG8_WAIT_L(8); PG8_BAR; PG8_WAIT_L(0); PG8_MMA(0, 0, At, B0); PG8_BAR; PG8_SCHED;
            PG8_LDB(B1, 0, 1); PG8_STAGE(PG8_SB(0, 0), b2, voffB);
            PG8_BAR; PG8_WAIT_L(0); PG8_MMA(0, 1, At, B1); PG8_BAR;
            PG8_LDA(At, 0, 1); PG8_STAGE(PG8_SA(0, 0), a2, voffA);
            PG8_BAR; PG8_WAIT_L(0); PG8_MMA(1, 0, At, B0); PG8_BAR; PG8_SCHED;
            PG8_STAGE(PG8_SB(0, 1), b2 + hstepB, voffB);
            PG8_WAIT_V(6); PG8_BAR; PG8_MMA(1, 1, At, B1); PG8_BAR;
            PG8_LDB(B0, 1, 0); PG8_SCHED; PG8_LDA(At, 1, 0); PG8_STAGE(PG8_SA(0, 1), a2 + hstep, voffA);
            PG8_WAIT_L(8); PG8_BAR; PG8_WAIT_L(0); PG8_MMA(0, 0, At, B0); PG8_BAR; PG8_SCHED;
            PG8_LDB(B1, 1, 1); PG8_STAGE(PG8_SB(1, 0), b3, voffB);
            PG8_BAR; PG8_WAIT_L(0); PG8_MMA(0, 1, At, B1); PG8_BAR;
            PG8_LDA(At, 1, 1); PG8_STAGE(PG8_SA(1, 0), a3, voffA);
            PG8_BAR; PG8_WAIT_L(0); PG8_MMA(1, 0, At, B0); PG8_BAR; PG8_SCHED;
            PG8_STAGE(PG8_SB(1, 1), b3 + hstepB, voffB);
            PG8_WAIT_V(6); PG8_BAR; PG8_MMA(1, 1, At, B1); PG8_BAR;
            }
        }
        if constexpr (ALIGN_EPI) { if (wr == 0) PG8_BAR; }
        if constexpr (!Epi::AFTER_DRAIN) { E(acc, cur, wr, wc, fr, fq); S.done(cur); }
        if (!has_next) break;
#pragma unroll
        for (int a = 0; a < 2; ++a)
#pragma unroll
            for (int b = 0; b < 2; ++b)
#pragma unroll
                for (int m = 0; m < 4; ++m)
#pragma unroll
                    for (int n = 0; n < 2; ++n) acc[a][b][m][n] = (f32x4){0.f, 0.f, 0.f, 0.f};
        cur = nxt; cA = nA; cB = nB; ++ui;
        if constexpr (ALIGN_EPI) { if (wr == 1) PG8_BAR; }
    }
    PG8_WAIT_V(0);
    if constexpr (!ALIGN_EPI) { if (wr == 0) PG8_BAR; }
    PG8_BAR;
    if constexpr (Epi::AFTER_DRAIN) { E.fused(acc, cur, wr, wc, fr, fq, lds, wid, lane); S.done(cur); }
#undef PG8_SA
#undef PG8_SB
#undef PG8_STAGE
#undef PG8_LDA
#undef PG8_LDB
#undef PG8_MMA
#undef PG8_WAIT_V
#undef PG8_WAIT_L
#undef PG8_BAR
#undef PG8_SCHED
}
}

constexpr int NWAVES = 8;
constexpr int D = 4096, NBATCH = 2, SEQ = 4096, CTXL = 256, ML = NBATCH * SEQ  , MC = NBATCH * CTXL  , MR = ML + MC  ;
constexpr int NIN = 24576, DFF = 16384, WA = 2048, NHEAD = 16, DK = 128, NMOD = 6 * D, NKB = MR / 16  ;
constexpr int C_FF = 0, C_FB = 2048, C_I = 4096, C_Q = 6144, C_G = 8192, C_BG = 10240, C_CG = 12288, C_H = 14336, C_GA = 16384, C_GB = 20480;
constexpr float LN_EPS = 1e-5f, RMS_EPS = 1e-6f;
constexpr float ALPHA = 1.41421356237309515f;
constexpr int KSPLIT = 32;

constexpr size_t MiB = 1u << 20;
constexpr size_t WS_CTL = 0, CTL_ZERO_BYTES = 1 * MiB;
constexpr size_t WS_MOD = 1 * MiB;
constexpr size_t WS_ST = WS_MOD + 768 * 1024;
constexpr size_t WS_PART = 2 * MiB;
constexpr size_t WS_WIN = 20 * MiB, SZ_WIN = 192 * MiB;
constexpr size_t WS_WAB = 404 * MiB, SZ_WAB = 32 * MiB;
constexpr size_t WS_WO = 468 * MiB, SZ_WO = 32 * MiB;
constexpr size_t WS_WUP = 532 * MiB, SZ_WUP = 128 * MiB;
constexpr size_t WS_WDN = 788 * MiB, SZ_WDN = 128 * MiB;
constexpr size_t WS_U = 1044 * MiB;
constexpr size_t WS_P = 1112 * MiB;
constexpr size_t WS_QT = 1520 * MiB;
constexpr size_t WS_KBT = 1588 * MiB;
constexpr size_t WS_VT = 1656 * MiB;
constexpr size_t WS_ATT = 1690 * MiB;
constexpr size_t WS_EXPB = 1707 * MiB;
constexpr size_t WS_OF = 1716 * MiB;
constexpr size_t WS_OB = 1784 * MiB;
constexpr size_t WS_OAZB = 1852 * MiB;
constexpr size_t WS_YPRE = 1920 * MiB;
constexpr size_t WS_R = 1988 * MiB;
constexpr size_t WS_X1 = 2124 * MiB;
constexpr size_t WS_X2 = 2260 * MiB;
constexpr size_t WS_H = 2396 * MiB;
constexpr size_t WS_YPART = 2668 * MiB;
constexpr size_t WS_END = 2736 * MiB;
constexpr size_t WS_SLAB = WS_QT;
static_assert(WS_PART + (size_t)2 * KSPLIT * 3 * NIN * 4 <= WS_WIN && WS_WIN + 2 * SZ_WIN <= WS_WAB && WS_WAB + 2 * SZ_WAB <= WS_WO && WS_WO + 2 * SZ_WO <= WS_WUP && WS_WUP + 2 * SZ_WUP <= WS_WDN && WS_WDN + 2 * SZ_WDN <= WS_U, "ws map (weights)");
static_assert(WS_U + (size_t)MR * D * 2 <= WS_P && WS_P + (size_t)MR * NIN * 2 <= WS_QT && WS_QT + (size_t)NKB * 16 * 2 * 4096 <= WS_KBT && WS_KBT + (size_t)NKB * 16 * 2 * 4096 <= WS_VT && WS_VT + (size_t)NKB * 16 * 4096 <= WS_ATT, "ws map (act 1)");
static_assert(WS_ATT + (size_t)NKB * 16 * 2 * 1024 <= WS_EXPB && WS_EXPB + (size_t)NKB * 16 * 2 * 512 <= WS_OF && WS_OF + (size_t)MR * WA * 4 <= WS_OB && WS_OB + (size_t)MR * WA * 4 <= WS_OAZB && WS_OAZB + (size_t)MR * D * 2 <= WS_YPRE, "ws map (act 2)");
static_assert(WS_YPRE + (size_t)MR * D * 2 <= WS_R && WS_R + (size_t)MR * D * 4 <= WS_X1 && WS_X1 + (size_t)MR * D * 4 <= WS_X2 && WS_X2 + (size_t)MR * D * 4 <= WS_H && WS_H + (size_t)MR * DFF * 2 <= WS_END, "ws map (act 3)");
constexpr int CW_BAR = 4096;

constexpr int RING_OFF = 0, RING_BYTES = 131072;
constexpr int LDSCTL_OFF = RING_BYTES, MISC_OFF = LDSCTL_OFF + 320;
constexpr int LDS_BYTES = 147456;

#define GAS __attribute__((address_space(1)))
#define CAS __attribute__((address_space(4)))
#define LAS __attribute__((address_space(3)))
#define DI __device__ __forceinline__
typedef unsigned short bf16;
typedef unsigned v4u __attribute__((ext_vector_type(4)));
typedef unsigned v2u __attribute__((ext_vector_type(2)));
typedef float f32x4 __attribute__((ext_vector_type(4)));
typedef float f32x2 __attribute__((ext_vector_type(2)));
typedef float f32x16 __attribute__((ext_vector_type(16)));
typedef short bf16x8 __attribute__((ext_vector_type(8)));
typedef GAS unsigned gu32;
#define RLX_AGENT __ATOMIC_RELAXED, __HIP_MEMORY_SCOPE_AGENT
#define LDS_WAIT() asm volatile("s_waitcnt lgkmcnt(0)" ::: "memory")
#define VM_WAIT() asm volatile("s_waitcnt vmcnt(0)" ::: "memory")
#define MFMA32(a, b, c) __builtin_amdgcn_mfma_f32_32x32x16_bf16((a), (b), (c), 0, 0, 0)
DI unsigned f2bf(float f) { unsigned u = __builtin_bit_cast(unsigned, f); return (u + 0x7fffu + ((u >> 16) & 1u)) >> 16; }
typedef __bf16 bf16x2_t __attribute__((ext_vector_type(2)));
DI unsigned pk2(float lo, float hi) { const f32x2 v = {lo, hi}; return __builtin_bit_cast(unsigned, __builtin_convertvector(v, bf16x2_t)); }
DI float bflo(unsigned w) { return __uint_as_float(w << 16); }
DI float bfhi(unsigned w) { return __uint_as_float(w & 0xffff0000u); }
constexpr float L2E = 1.44269504088896341f;
DI float ex2(float x) { return __builtin_amdgcn_exp2f(x); }
DI float sigmoidf_(float x) { return __builtin_amdgcn_rcpf(1.f + ex2(-L2E * x)); }
DI int sigma16(int p) { return 8 * ((p >> 2) & 1) + 4 * (p >> 3) + (p & 3); }

#define XB_TMO      128
#define XB_XCNT(j)  (256  + 64 * (j))
#define XB_XSUB(j)  (1280 + 64 * (j))
#define XB_XGEN(j)  (2304 + 64 * (j))
#define XB_TOP      3328
#define XB_TOPGEN   3392
#define XCD_BAR_WORDS 3456
#define XB_SPIN_CAP (1u << 18)

__device__ __forceinline__ unsigned xb_ld(unsigned* p)              { return __hip_atomic_load(p, __ATOMIC_RELAXED, __HIP_MEMORY_SCOPE_AGENT); }
__device__ __forceinline__ unsigned xb_add(unsigned* p, unsigned v) { return __hip_atomic_fetch_add(p, v, __ATOMIC_RELAXED, __HIP_MEMORY_SCOPE_AGENT); }
__device__ __forceinline__ unsigned xb_xcc_id() { return (unsigned)__builtin_amdgcn_s_getreg((3 << 11) | 20) & 0xFu; }
#define XB_SPIN(cond, bar) do { unsigned _sp = 0; while (cond) { __builtin_amdgcn_s_sleep(1); \
    if ((++_sp & 255u) == 0u) { if (xb_ld(&(bar)[XB_TMO])) break; if (_sp > XB_SPIN_CAP) { atomicAdd(&(bar)[XB_TMO], 1u); break; } } } } while (0)

struct XcdBarrier {
    unsigned* bar; unsigned x;
    volatile LAS unsigned* st;
};

__device__ __forceinline__ XcdBarrier xcd_barrier_post(unsigned* bar, volatile LAS unsigned* st) {
    XcdBarrier b; b.bar = bar; b.x = xb_xcc_id(); b.st = st;
    if (threadIdx.x == 0) (void)xb_add(&bar[XB_XCNT(b.x)], 1u);
    return b;
}
__device__ __forceinline__ void xcd_barrier_complete(unsigned* bar, unsigned x, unsigned& nloc, unsigned& nx) {
    const unsigned G = gridDim.x * gridDim.y * gridDim.z;
    unsigned sum, cnt, mine, sp = 0u;
    for (;;) {
        sum = 0u; cnt = 0u; mine = 0u;
#pragma unroll
        for (unsigned j = 0; j < 16; ++j) { const unsigned c = xb_ld(&bar[XB_XCNT(j)]); sum += c; cnt += (c > 0u) ? 1u : 0u; mine = (j == x) ? c : mine; }
        if (sum == G) break;
        __builtin_amdgcn_s_sleep(1);
        if ((++sp & 255u) == 0u) { if (xb_ld(&bar[XB_TMO])) break; if (sp > XB_SPIN_CAP) { atomicAdd(&bar[XB_TMO], 1u); break; } }
    }
    nloc = mine > 0u ? mine : 1u; nx = cnt > 0u ? cnt : 1u;
}

__device__ __forceinline__ void xcd_barrier(const XcdBarrier& b) {
    asm volatile("s_waitcnt vmcnt(0)" ::: "memory");
    __syncthreads();
    if (threadIdx.x == 0) {
        unsigned* bar = b.bar;
        unsigned bx = b.x; asm volatile("" : "+s"(bx));
        __builtin_amdgcn_s_waitcnt(0);
        unsigned nloc = b.st[0], nx = b.st[1];
        if (nloc == 0u) { xcd_barrier_complete(bar, bx, nloc, nx); b.st[0] = nloc; b.st[1] = nx; }
        const unsigned old = xb_add(&bar[XB_XSUB(bx)], 1u);
        const unsigned gen = old / nloc;
        if (old + 1u == (gen + 1u) * nloc) {
            __builtin_amdgcn_fence(__ATOMIC_RELEASE, "agent");
            asm volatile("s_waitcnt vmcnt(0)" ::: "memory");
            const unsigned og = xb_add(&bar[XB_TOP], 1u);
            const unsigned tg = og / nx;
            if (og + 1u == (tg + 1u) * nx) xb_add(&bar[XB_TOPGEN], 1u);
            else XB_SPIN(xb_ld(&bar[XB_TOPGEN]) == tg, bar);
            __builtin_amdgcn_fence(__ATOMIC_ACQUIRE, "agent");
            xb_add(&bar[XB_XGEN(bx)], 1u);
            asm volatile("s_waitcnt vmcnt(0)" ::: "memory");
        } else {
            XB_SPIN(xb_ld(&bar[XB_XGEN(bx)]) == gen, bar);
            __builtin_amdgcn_fence(__ATOMIC_ACQUIRE, "agent");
            asm volatile("s_waitcnt vmcnt(0)" ::: "memory");
        }
    }
    __syncthreads();
}

struct Frame {
    LAS unsigned char* lds;
    volatile LAS unsigned* MISC;
    gu32* ctl;
    int tid, lane, wave;
    int G;
    unsigned char* ws;
};
DI float shfl_x(float v, int o, int lane) { return __int_as_float(__builtin_amdgcn_ds_bpermute((lane ^ o) << 2, __float_as_int(v))); }
DI float wave_sum(float v) {
#pragma unroll
    for (int o = 1; o < 64; o <<= 1) v += __shfl_xor(v, o);
    return v;
}
DI int row_vec(int row) { return row < SEQ ? 0 : (row < ML ? 1 : 2); }

struct P0Item { const float* src; bf16* dst; int N; };
DI void p0_load(const P0Item& it, int lane, f32x4 (&v)[8]) {
#pragma unroll
    for (int i = 0; i < 8; ++i) v[i] = *(const GAS f32x4*)(it.src + (size_t)(8 * i + (lane >> 3)) * it.N + (lane & 7) * 4);
}
DI void p0_emit(const P0Item& it, const f32x4 (&v)[8], LAS float* scr, int lane) {
#pragma unroll
    for (int i = 0; i < 8; ++i) { LAS float* w = scr + (8 * i + (lane >> 3)) * 33 + (lane & 7) * 4; w[0] = v[i][0]; w[1] = v[i][1]; w[2] = v[i][2]; w[3] = v[i][3]; }
    LDS_WAIT(); asm volatile("" ::: "memory");
#pragma unroll
    for (int jj = 0; jj < 4; ++jj) { const int q = 64 * jj + lane, n = q >> 3, c = q & 7; const LAS float* s = scr + (8 * c) * 33 + n;
        v4u o; o.x = pk2(s[0 * 33], s[1 * 33]); o.y = pk2(s[2 * 33], s[3 * 33]); o.z = pk2(s[4 * 33], s[5 * 33]); o.w = pk2(s[6 * 33], s[7 * 33]);
        *(GAS v4u*)(it.dst + (size_t)q * 8) = o; }
    LDS_WAIT(); asm volatile("" ::: "memory");
}
struct P0Args { const float *c, *c_ctx, *w_ada, *w_in, *w_out_a, *w_out_b, *w_o, *w_up, *w_down; };
constexpr int I_IN = (D / 64) * (NIN / 32), I_OA = (WA / 64) * (D / 32), I_O = (D / 64) * (D / 32), I_UP = (D / 64) * (DFF / 32), I_DN = (DFF / 64) * (D / 32);
constexpr int I_LAYER = I_IN + 2 * I_OA + I_O + I_UP + I_DN;
constexpr int BG_N1 = 9600  , BG_N3 = 15680  , BG_N4 = 19200  , BG_N5 = 9600  ;
constexpr int BG_S0 = I_LAYER - (BG_N1 + BG_N3 + BG_N4 + BG_N5);
constexpr int BG_S1 = BG_S0 + BG_N1, BG_S2 = BG_S1, BG_S3 = BG_S2 + BG_N3, BG_S4 = BG_S3 + BG_N4, BG_S5 = BG_S4 + BG_N5;
static_assert(BG_S0 >= I_IN && BG_S5 == I_LAYER, "layer 1's w_in is converted in the prologue (the last slot runs inside layer 1's w_in phase); the slots end the layer");
DI void convert_items(Frame& F, const P0Args& A, int lo, int hi, int gw, int NGW, LAS float* scr) {
    auto decode = [&](int itn, P0Item& o) {
        const int l = itn / I_LAYER; int r = itn % I_LAYER;
        const float* W; bf16* WT; int N, Ktot, koff = 0;
        if (r < I_IN) { W = A.w_in + (size_t)l * D * NIN; WT = (bf16*)(F.ws + WS_WIN + l * SZ_WIN); N = NIN; Ktot = D; }
        else if ((r -= I_IN) < I_OA) { W = A.w_out_a + (size_t)l * WA * D; WT = (bf16*)(F.ws + WS_WAB + l * SZ_WAB); N = D; Ktot = D; }
        else if ((r -= I_OA) < I_OA) { W = A.w_out_b + (size_t)l * WA * D; WT = (bf16*)(F.ws + WS_WAB + l * SZ_WAB); N = D; Ktot = D; koff = WA; }
        else if ((r -= I_OA) < I_O) { W = A.w_o + (size_t)l * D * D; WT = (bf16*)(F.ws + WS_WO + l * SZ_WO); N = D; Ktot = D; }
        else if ((r -= I_O) < I_UP) { W = A.w_up + (size_t)l * D * DFF; WT = (bf16*)(F.ws + WS_WUP + l * SZ_WUP); N = DFF; Ktot = D; }
        else { r -= I_UP; W = A.w_down + (size_t)l * DFF * D; WT = (bf16*)(F.ws + WS_WDN + l * SZ_WDN); N = D; Ktot = DFF; }
        const int nblk = N / 32, kb = r / nblk, nb = r % nblk, k0 = 64 * kb, n0 = 32 * nb;
        o.src = W + (size_t)k0 * N + n0; o.N = N;
        o.dst = WT + (((size_t)(n0 >> 8) * (Ktot / 64) + ((koff + k0) >> 6)) * 256 + (n0 & 255)) * 64;
    };
    int itn = lo + gw; P0Item ia, ib; f32x4 va[8], vb[8];
    if (itn < hi) { decode(itn, ia); p0_load(ia, F.lane, va); }
    while (itn < hi) {
        const int i2 = itn + NGW; if (i2 < hi) { decode(i2, ib); p0_load(ib, F.lane, vb); }
        p0_emit(ia, va, scr, F.lane);
        if (i2 >= hi) break;
        const int i3 = i2 + NGW; if (i3 < hi) { decode(i3, ia); p0_load(ia, F.lane, va); }
        p0_emit(ib, vb, scr, F.lane);
        itn = i3;
    }
}
DI void bg_convert(Frame& F, const P0Args& A, int wg0, int lo, int hi) {
    if ((int)blockIdx.x < wg0) return;
    const int gw = ((int)blockIdx.x - wg0) * NWAVES + F.wave, NGW = (F.G - wg0) * NWAVES;
    convert_items(F, A, I_LAYER + lo, I_LAYER + hi, gw, NGW, (LAS float*)(F.lds + RING_OFF + F.wave * 16384));
}
DI void phase0(Frame& F, const P0Args& A) {
    LAS float* sv = (LAS float*)(F.lds + RING_OFF);
    for (int i = F.tid; i < 3 * D; i += NWAVES * 64) { const int v = i / D, k = i % D; const float x = v < 2 ? A.c[v * D + k] : A.c_ctx[k]; sv[i] = x * sigmoidf_(x); }
    __syncthreads();
    const int gw = blockIdx.x * NWAVES + F.wave, NGW = F.G * NWAVES;
    float* part = (float*)(F.ws + WS_PART);
    constexpr int NCG = NIN / 256, NTASK = 2 * KSPLIT * NCG;
    for (int tk = gw; tk < NTASK; tk += NGW) {
        const int l = tk / (KSPLIT * NCG), rem = tk % (KSPLIT * NCG), kc = rem / NCG, cg = rem % NCG;
        const int n0 = cg * 256 + F.lane * 4, k0 = kc * (D / KSPLIT);
        const float* wp = A.w_ada + ((size_t)l * D + k0) * NIN + n0;
        f32x4 a0 = {0.f, 0.f, 0.f, 0.f}, a1 = a0, a2 = a0;
#pragma unroll 8
        for (int k = 0; k < D / KSPLIT; ++k) { const f32x4 w = *(const GAS f32x4*)(wp + (size_t)k * NIN);
            a0 += w * sv[k0 + k]; a1 += w * sv[D + k0 + k]; a2 += w * sv[2 * D + k0 + k]; }
        float* pp = part + ((size_t)(l * KSPLIT + kc) * 3) * NIN + n0;
        *(f32x4*)(pp) = a0; *(f32x4*)(pp + NIN) = a1; *(f32x4*)(pp + 2 * NIN) = a2;
    }
    __syncthreads();
    convert_items(F, A, 0, I_LAYER, gw, NGW, (LAS float*)(F.lds + RING_OFF + F.wave * 16384));
    convert_items(F, A, I_LAYER, I_LAYER + BG_S0, gw, NGW, (LAS float*)(F.lds + RING_OFF + F.wave * 16384));
}
DI void phase1(Frame& F, const float* b_ada) {
    const float* part = (const float*)(F.ws + WS_PART); float* mod = (float*)(F.ws + WS_MOD);
    for (int i = blockIdx.x * (NWAVES * 64) + F.tid; i < 2 * 3 * NIN; i += F.G * NWAVES * 64) {
        const int l = i / (3 * NIN), rem = i % (3 * NIN), v = rem / NIN, n = rem % NIN;
        float s = b_ada[l * NIN + n];
#pragma unroll 8
        for (int kc = 0; kc < KSPLIT; ++kc) s += part[((size_t)(l * KSPLIT + kc) * 3 + v) * NIN + n];
        mod[i] = s;
    }
}
DI void phase_modulate0(Frame& F, const float* x, const float* ctx) {
    const float* mod = (const float*)(F.ws + WS_MOD); bf16* U = (bf16*)(F.ws + WS_U);
    const int gw = blockIdx.x * NWAVES + F.wave, NGW = F.G * NWAVES;
    for (int row = gw; row < MR; row += NGW) {
        const float* xr = row < ML ? x + (size_t)row * D : ctx + (size_t)(row - ML) * D;
        const float* mv = mod + row_vec(row) * NIN;
        bf16* ur = U + (size_t)row * D;
#pragma unroll 4
        for (int j = 0; j < 16; ++j) { const int c = j * 256 + F.lane * 4;
            const f32x4 v = *(const GAS f32x4*)(xr + c), sh = *(const f32x4*)(mv + c), sc = *(const f32x4*)(mv + D + c);
            const f32x4 o = v * (sc + 1.f) + sh; v2u w; w.x = pk2(o[0], o[1]); w.y = pk2(o[2], o[3]); *(GAS v2u*)(ur + c) = w; }
    }
}
template <bool HAS_MOD, bool CTX_SPLIT>
DI void phase_ln(Frame& F, const float* R, const float* g, const float* b, float* xo, int xo_from  , float* st  , int nrows, const float* mv_base  , int sh_off, int sc_off,
                 const float* slab  , const float* xres_ctx  , const float* gate_ctx  ) {
    bf16* U = (bf16*)(F.ws + WS_U);
    LAS float* red1 = (LAS float*)(F.lds + RING_OFF); LAS float* red2 = red1 + 64;
    const int nlat = CTX_SPLIT ? ML / F.G : 0, nctx = CTX_SPLIT ? MC / F.G : 0;
    const int rpw = CTX_SPLIT ? nlat + nctx : (nrows + F.G - 1) / F.G, row0 = blockIdx.x * rpw;
#define LN_ROW(k) (CTX_SPLIT ? ((k) < nlat ? (int)blockIdx.x * nlat + (k) : ML + (int)blockIdx.x * nctx + ((k) - nlat)) : row0 + (k))
    const int c0 = F.wave * 512 + F.lane * 8;
    f32x4 gc0 = {0.f, 0.f, 0.f, 0.f}, gc1 = gc0;
    if (CTX_SPLIT) { gc0 = *(const f32x4*)(gate_ctx + c0); gc1 = *(const f32x4*)(gate_ctx + c0 + 4); }
    const f32x4 g0 = *(const f32x4*)(g + c0), g1 = *(const f32x4*)(g + c0 + 4), b0 = *(const f32x4*)(b + c0), b1 = *(const f32x4*)(b + c0 + 4);
    f32x4 sc0 = {0.f, 0.f, 0.f, 0.f}, sc1 = sc0, sh0 = sc0, sh1 = sc0; int cur_vec = -1;
    auto ln_load = [&](int rb, f32x4 (&v)[8][2]) {
#pragma unroll
        for (int i = 0; i < 8; ++i) { const int row = LN_ROW(rb + i); const bool ok = (rb + i < rpw) && row < nrows;
            if (ok && CTX_SPLIT && row >= ML) { const size_t ro = (size_t)(row - ML) * D + c0;
                f32x4 a0 = *(const GAS f32x4*)(slab + ro), a1 = *(const GAS f32x4*)(slab + ro + 4);
#pragma unroll
                for (int kc = 1; kc < 8; ++kc) { a0 += *(const GAS f32x4*)(slab + (size_t)kc * MC * D + ro); a1 += *(const GAS f32x4*)(slab + (size_t)kc * MC * D + ro + 4); }
                v[i][0] = *(const GAS f32x4*)(xres_ctx + ro) * ALPHA + gc0 * a0; v[i][1] = *(const GAS f32x4*)(xres_ctx + ro + 4) * ALPHA + gc1 * a1; }
            else if (ok) { const float* rr = R + (size_t)row * D + c0; v[i][0] = *(const GAS f32x4*)rr; v[i][1] = *(const GAS f32x4*)(rr + 4); }
            else { v[i][0] = (f32x4){0.f, 0.f, 0.f, 0.f}; v[i][1] = v[i][0]; } }
    };
    auto ln_process = [&](int rb, f32x4 (&v)[8][2]) {
        float s[8];
#pragma unroll
        for (int i = 0; i < 8; ++i) s[i] = ((v[i][0][0] + v[i][0][1]) + (v[i][0][2] + v[i][0][3])) + ((v[i][1][0] + v[i][1][1]) + (v[i][1][2] + v[i][1][3]));
#pragma unroll
        for (int o = 1; o < 64; o <<= 1) {
#pragma unroll
            for (int i = 0; i < 8; ++i) s[i] += shfl_x(s[i], o, F.lane); }
        if (F.lane < 8) { float t = s[0];
#pragma unroll
            for (int i = 1; i < 8; ++i) t = F.lane == i ? s[i] : t;
            red1[F.lane * 8 + F.wave] = t; }
        __syncthreads();
        float mean[8];
#pragma unroll
        for (int i = 0; i < 8; ++i) { const f32x4 p0 = *(const LAS f32x4*)(red1 + i * 8), p1 = *(const LAS f32x4*)(red1 + i * 8 + 4);
            mean[i] = (((p0[0] + p0[1]) + (p0[2] + p0[3])) + ((p1[0] + p1[1]) + (p1[2] + p1[3]))) * (1.f / D); }
#pragma unroll
        for (int i = 0; i < 8; ++i) { v[i][0] = v[i][0] - mean[i]; v[i][1] = v[i][1] - mean[i];
            s[i] = ((v[i][0][0] * v[i][0][0] + v[i][0][1] * v[i][0][1]) + (v[i][0][2] * v[i][0][2] + v[i][0][3] * v[i][0][3])) + ((v[i][1][0] * v[i][1][0] + v[i][1][1] * v[i][1][1]) + (v[i][1][2] * v[i][1][2] + v[i][1][3] * v[i][1][3])); }
#pragma unroll
        for (int o = 1; o < 64; o <<= 1) {
#pragma unroll
            for (int i = 0; i < 8; ++i) s[i] += shfl_x(s[i], o, F.lane); }
        if (F.lane < 8) { float t = s[0];
#pragma unroll
            for (int i = 1; i < 8; ++i) t = F.lane == i ? s[i] : t;
            red2[F.lane * 8 + F.wave] = t; }
        __syncthreads();
#pragma unroll
        for (int i = 0; i < 8; ++i) { const int row = LN_ROW(rb + i); const bool ok = (rb + i < rpw) && row < nrows;
            const f32x4 p0 = *(const LAS f32x4*)(red2 + i * 8), p1 = *(const LAS f32x4*)(red2 + i * 8 + 4);
            const float var = (((p0[0] + p0[1]) + (p0[2] + p0[3])) + ((p1[0] + p1[1]) + (p1[2] + p1[3]))) * (1.f / D);
            const float rstd = 1.f / sqrtf(var + LN_EPS);
            if (ok) {
                const f32x4 y0 = v[i][0] * rstd * g0 + b0, y1 = v[i][1] * rstd * g1 + b1;
                if (row >= xo_from) { float* xr = xo + (size_t)row * D + c0; *(GAS f32x4*)xr = y0; *(GAS f32x4*)(xr + 4) = y1; }
                if (st && F.tid == 0) *(GAS f32x2*)(st + (size_t)row * 2) = (f32x2){mean[i], rstd};
                if (HAS_MOD) { const int vec = row_vec(row);
                    if (vec != cur_vec) { const float* mv = mv_base + vec * NIN + c0; sc0 = *(const f32x4*)(mv + sc_off); sc1 = *(const f32x4*)(mv + sc_off + 4); sh0 = *(const f32x4*)(mv + sh_off); sh1 = *(const f32x4*)(mv + sh_off + 4); cur_vec = vec; }
                    const f32x4 o0 = y0 * (sc0 + 1.f) + sh0, o1 = y1 * (sc1 + 1.f) + sh1;
                    v4u w; w.x = pk2(o0[0], o0[1]); w.y = pk2(o0[2], o0[3]); w.z = pk2(o1[0], o1[1]); w.w = pk2(o1[2], o1[3]);
                    *(GAS v4u*)(U + (size_t)row * D + c0) = w; } } }
    };
    f32x4 va[8][2], vb[8][2];
    ln_load(0, va);
    for (int rb = 0; rb < rpw; rb += 16) {
        if (rb + 8 < rpw) ln_load(rb + 8, vb);
        ln_process(rb, va);
        if (rb + 8 >= rpw) break;
        if (rb + 16 < rpw) ln_load(rb + 16, va);
        ln_process(rb + 8, vb);
    }
    __syncthreads();
#undef LN_ROW
}
DI void prep_task(Frame& F, const bf16* P, const float* lbnd  , int layer, int kb, int head, LAS unsigned char* wl  , int nost  ) {
    const int lane = F.lane;
    const bf16* prow = P + (size_t)(16 * kb) * NIN + head * DK + 2 * lane;
    unsigned zf[16], zb[16], qq[16], vv[16];
#pragma unroll
    for (int t = 0; t < 16; ++t) { const bf16* pr = prow + (size_t)t * NIN;
        zf[t] = *(const GAS unsigned*)(pr + C_FF); zb[t] = *(const GAS unsigned*)(pr + C_FB); qq[t] = *(const GAS unsigned*)(pr + C_Q); vv[t] = *(const GAS unsigned*)(pr + C_I); }
    const size_t kh = (size_t)kb * 16 + head;
    {
        unsigned lo[8], hi[8];
#pragma unroll
        for (int m = 0; m < 8; ++m) { const int s0 = sigma16(2 * m); lo[m] = (vv[s0] & 0xffffu) | (vv[s0 + 1] << 16); hi[m] = (vv[s0] >> 16) | (vv[s0 + 1] & 0xffff0000u); }
        GAS v4u* o = (GAS v4u*)(F.ws + WS_VT + kh * 4096 + (size_t)(2 * lane) * 32);
        if (!nost) { o[0] = (v4u){lo[0], lo[1], lo[2], lo[3]}; o[1] = (v4u){lo[4], lo[5], lo[6], lo[7]}; o[2] = (v4u){hi[0], hi[1], hi[2], hi[3]}; o[3] = (v4u){hi[4], hi[5], hi[6], hi[7]}; }
    }
    float qs0[16], qs1[16];
#pragma unroll
    for (int t = 0; t < 16; ++t) { const float a = bflo(qq[t]), b = bfhi(qq[t]); qs0[t] = a * sigmoidf_(a); qs1[t] = b * sigmoidf_(b); }
    LAS unsigned char* lq = wl; LAS unsigned char* lk = wl + 16 * 272;
    const int d0 = 2 * lane, dpos = 16 * (d0 >> 4) + sigma16(d0 & 15);
    const int dl = d0 & 31, epos = (d0 >> 5) * 32 + ((dl >> 2) & 1) * 16 + ((dl & 3) | ((dl >> 3) << 2));
#pragma unroll
    for (int dir = 0; dir < 2; ++dir) {
        const size_t idx = kh * 2 + dir;
        float lb0 = 0.f, lb1 = 0.f;
        if (layer == 1) { const float* lp = lbnd + dir * WA + head * DK + d0;
            lb0 = __builtin_amdgcn_rcpf(1.f + ex2(L2E * (lp[0] - lp[2 * WA]))); lb1 = __builtin_amdgcn_rcpf(1.f + ex2(L2E * (lp[1] - lp[2 * WA + 1]))); }
        float b0[16], b1[16], k0[16], k1[16]; float c0 = 0.f, c1 = 0.f;
#pragma unroll
        for (int i = 0; i < 16; ++i) { const int t = dir ? 15 - i : i; const unsigned zw = dir ? zb[t] : zf[t];
            const float z0 = bflo(zw), z1 = bfhi(zw);
            const float e0 = ex2(-L2E * fabsf(z0)), e1 = ex2(-L2E * fabsf(z1)), r0 = __builtin_amdgcn_rcpf(1.f + e0), r1 = __builtin_amdgcn_rcpf(1.f + e1);
            const float sp0 = z0 >= 0.f ? r0 : e0 * r0, sm0 = z0 >= 0.f ? e0 * r0 : r0, sp1 = z1 >= 0.f ? r1 : e1 * r1, sm1 = z1 >= 0.f ? e1 * r1 : r1;
            c0 += __builtin_amdgcn_logf(fmaxf(lb0 + (1.f - lb0) * sp0, 1e-37f)); c1 += __builtin_amdgcn_logf(fmaxf(lb1 + (1.f - lb1) * sp1, 1e-37f));
            b0[t] = c0; b1[t] = c1; k0[t] = (1.f - lb0) * sm0; k1[t] = (1.f - lb1) * sm1; }
        float kb0[16], kb1[16];
#pragma unroll
        for (int t = 0; t < 16; ++t) {
            const float eb0 = ex2(b0[t]), eb1 = ex2(b1[t]);
            const unsigned qt = pk2(qs0[t] * eb0, qs1[t] * eb1);
            const unsigned kt = pk2(k0[t] * ex2(fminf(-b0[t], 115.f)), k1[t] * ex2(fminf(-b1[t], 115.f)));
            kb0[t] = k0[t] * ex2(c0 - b0[t]); kb1[t] = k1[t] * ex2(c1 - b1[t]);
            *(LAS unsigned*)(lq + t * 272 + 4 * lane) = qt; *(LAS unsigned*)(lk + t * 272 + 4 * lane) = kt;
            if (!nost) *(GAS unsigned*)(F.ws + WS_QT + idx * 4096 + (size_t)t * 256 + dpos * 2) = qt; }
        {
            unsigned w0[8], w1[8];
#pragma unroll
            for (int m = 0; m < 8; ++m) { const int s0 = sigma16(2 * m); w0[m] = pk2(kb0[s0], kb0[s0 + 1]); w1[m] = pk2(kb1[s0], kb1[s0 + 1]); }
            GAS v4u* o = (GAS v4u*)(F.ws + WS_KBT + idx * 4096 + (size_t)d0 * 32);
            if (!nost) { o[0] = (v4u){w0[0], w0[1], w0[2], w0[3]}; o[1] = (v4u){w0[4], w0[5], w0[6], w0[7]}; o[2] = (v4u){w1[0], w1[1], w1[2], w1[3]}; o[3] = (v4u){w1[4], w1[5], w1[6], w1[7]}; }
        }
        if (!nost) *(GAS f32x2*)(F.ws + WS_EXPB + idx * 512 + (size_t)epos * 4) = (f32x2){ex2(c0), ex2(c1)};
        LDS_WAIT(); asm volatile("" ::: "memory");
        const int r = lane & 31, hh = lane >> 5;
        f32x16 X;
#pragma unroll
        for (int i = 0; i < 16; ++i) X[i] = 0.f;
#pragma unroll
        for (int ks = 0; ks < 8; ++ks) { const int off = (r & 15) * 272 + (16 * ks + 8 * hh) * 2;
            const bf16x8 ak = *(const LAS bf16x8*)(lk + off), bq = *(const LAS bf16x8*)(lq + off); X = MFMA32(ak, bq, X); }
        unsigned aw[4];
#pragma unroll
        for (int w = 0; w < 4; ++w) { const int j0 = 2 * w, j1 = 2 * w + 1, s0 = (j0 & 3) + 8 * (j0 >> 2) + 4 * hh, s1 = (j1 & 3) + 8 * (j1 >> 2) + 4 * hh;
            const bool k0_ = r < 16 && (dir ? s0 >= r : s0 <= r), k1_ = r < 16 && (dir ? s1 >= r : s1 <= r);
            aw[w] = pk2(k0_ ? X[j0] : 0.f, k1_ ? X[j1] : 0.f); }
        if (!nost) *(GAS v4u*)(F.ws + WS_ATT + idx * 1024 + (size_t)lane * 16) = (v4u){aw[0], aw[1], aw[2], aw[3]};
        asm volatile("" ::: "memory");
    }
}
constexpr int SC_Q = 0, SC_K = 4096, SC_V = 8192, SC_A = 12288, SC_E = 13312, SC_SLOT = 13824, SC_NSLOT = 8, SC_PD = SC_NSLOT - 1  , SC_WGS = 64, SC_NSTEP = 16 + 256;
DI int scan_kb(int j, int b, int dir) { if (j < 16) return 512 + 16 * b + (dir ? 15 - j : j); const int jj = j - 16; return 256 * b + (dir ? 255 - jj : jj); }
DI void scan_issue(const unsigned char* ws, LAS unsigned char* slot, int kb, int head, int dir, int h  , int lane) {
    const size_t kh = (size_t)kb * 16 + head, idx = kh * 2 + dir;
    __builtin_amdgcn_global_load_lds((const unsigned*)(ws + WS_QT + idx * 4096 + (size_t)((lane & 15) * 256 + (4 * h + (lane >> 4)) * 16)), (LAS unsigned*)(slot + SC_Q + h * 1024), 16, 0, 0);
    const size_t ro = (size_t)((64 * (h & 1) + lane) * 32 + (h >> 1) * 16);
    __builtin_amdgcn_global_load_lds((const unsigned*)(ws + WS_KBT + idx * 4096 + ro), (LAS unsigned*)(slot + SC_K + h * 1024), 16, 0, 0);
    __builtin_amdgcn_global_load_lds((const unsigned*)(ws + WS_VT + kh * 4096 + ro), (LAS unsigned*)(slot + SC_V + h * 1024), 16, 0, 0);
    if (h == 1 || h == 2) __builtin_amdgcn_global_load_lds((const unsigned*)(ws + WS_EXPB + idx * 512 + (size_t)(h - 1) * 256 + (size_t)lane * 4), (LAS unsigned*)(slot + SC_E + (h - 1) * 256), 4, 0, 0);
    else __builtin_amdgcn_global_load_lds((const unsigned*)(ws + WS_ATT + idx * 1024 + (size_t)lane * 16), (LAS unsigned*)(slot + SC_A), 16, 0, 0);
}
DI bf16x8 pack_rows(const f32x16& x, int s) {
    v4u p; p.x = pk2(x[8 * s], x[8 * s + 1]); p.y = pk2(x[8 * s + 2], x[8 * s + 3]); p.z = pk2(x[8 * s + 4], x[8 * s + 5]); p.w = pk2(x[8 * s + 6], x[8 * s + 7]);
    return __builtin_bit_cast(bf16x8, p);
}
DI void scan_step(f32x16 (&S)[4], const LAS unsigned char* slot, int vg, bf16* orow  , int lane) {
    const int r = lane & 31, hh = lane >> 5;
    const LAS unsigned char* qp = slot + SC_Q + (hh * 16 + (r & 15)) * 16;
    const LAS unsigned char* kp = slot + SC_K + (hh * 128 + r) * 16;
    const LAS f32x4* ep = (const LAS f32x4*)(slot + SC_E + hh * 64);
    bf16x8 qf[8], kf[4]; f32x4 e[4][4];
#pragma unroll
    for (int ks = 0; ks < 8; ++ks) qf[ks] = *(const LAS bf16x8*)(qp + ks * 512);
    const bf16x8 af = *(const LAS bf16x8*)(slot + SC_A + lane * 16), vf = *(const LAS bf16x8*)(slot + SC_V + (hh * 128 + 32 * vg + r) * 16);
#pragma unroll
    for (int dt = 0; dt < 4; ++dt) { kf[dt] = *(const LAS bf16x8*)(kp + dt * 512);
#pragma unroll
        for (int g = 0; g < 4; ++g) e[dt][g] = ep[dt * 8 + g]; }
    asm volatile("" ::: "memory");
    f32x16 O;
#pragma unroll
    for (int i = 0; i < 16; ++i) O[i] = 0.f;
#pragma unroll
    for (int dt = 0; dt < 4; ++dt)
#pragma unroll
        for (int s2 = 0; s2 < 2; ++s2) O = MFMA32(qf[2 * dt + s2], pack_rows(S[dt], s2), O);
    O = MFMA32(af, vf, O);
#pragma unroll
    for (int dt = 0; dt < 4; ++dt) {
#pragma unroll
        for (int c = 0; c < 4; ++c) { S[dt][c] *= e[dt][0][c]; S[dt][4 + c] *= e[dt][1][c]; S[dt][8 + c] *= e[dt][2][c]; S[dt][12 + c] *= e[dt][3][c]; }
        S[dt] = MFMA32(kf[dt], vf, S[dt]);
    }
#pragma unroll
    for (int i = 0; i < 8; i += 2) { const unsigned w = pk2(O[i], O[i + 1]);
        *(GAS bf16*)(orow + (size_t)((i & 3) + 8 * (i >> 2) + 4 * hh) * WA) = (bf16)(w & 0xffffu); *(GAS bf16*)(orow + (size_t)(((i + 1) & 3) + 8 * ((i + 1) >> 2) + 4 * hh) * WA) = (bf16)(w >> 16); }
}
#define SC_WAIT(n) asm volatile("s_waitcnt vmcnt(" #n ")" ::: "memory")
#define SC_WAITN(n) asm volatile("s_waitcnt vmcnt(%0)" :: "n"(n) : "memory")
#define SC_BAR() do { asm volatile("" ::: "memory"); __builtin_amdgcn_s_barrier(); asm volatile("" ::: "memory"); } while (0)
DI void scan_wg(Frame& F, int stream) {
    const int lane = F.lane, dir = stream & 1, head = (stream >> 1) & 15, b = stream >> 5;
    LAS unsigned char* ring = F.lds + RING_OFF;
    if (F.wave >= 4) {
        const int h = F.wave - 4;
#pragma unroll
        for (int i = 0; i < SC_PD; ++i) scan_issue(F.ws, ring + i * SC_SLOT, scan_kb(i, b, dir), head, dir, h, lane);
        SC_WAITN(4 * (SC_PD - 1)); SC_BAR();
        for (int j = 0; j < SC_NSTEP; ++j) {
            const int jn = j + SC_PD < SC_NSTEP ? j + SC_PD : SC_NSTEP - 1;
            scan_issue(F.ws, ring + ((j + SC_PD) & (SC_NSLOT - 1)) * SC_SLOT, scan_kb(jn, b, dir), head, dir, h, lane);
            SC_WAITN(4 * (SC_PD - 1)); SC_BAR();
        }
        SC_WAIT(0);
    } else {
        const int vg = F.wave, r = lane & 31;
        bf16* obase = (bf16*)(F.ws + (dir ? WS_OB : WS_OF)) + head * DK + 32 * vg + r;
        f32x16 S[4];
#pragma unroll
        for (int dt = 0; dt < 4; ++dt)
#pragma unroll
            for (int i = 0; i < 16; ++i) S[dt][i] = 0.f;
        SC_BAR();
        for (int j = 0; j < SC_NSTEP; ++j) {
            scan_step(S, ring + (j & (SC_NSLOT - 1)) * SC_SLOT, vg, obase + (size_t)(16 * scan_kb(j, b, dir)) * WA, lane);
            SC_BAR();
        }
    }
}
DI void conv_strip(Frame& F, const float* cw  , int task) {
    const bf16* P = (const bf16*)(F.ws + WS_P); bf16* OZ = (bf16*)(F.ws + WS_OAZB);
    const int strip = task >> 2, ch = (task & 3) * 512 + F.lane * 8, row0 = strip * 8;
    const bool hp = row0 < ML ? (row0 & 63) != 0 : ((row0 - ML) & (CTXL - 1)) != 0;
    const bool hn = row0 < ML ? ((row0 + 8) & 63) != 0 : ((row0 + 8 - ML) & (CTXL - 1)) != 0;
    const bf16* pr = P + (size_t)row0 * NIN + ch;
    v4u cg[10], hg[10], bg[8];
#pragma unroll
    for (int j = 0; j < 10; ++j) { const bool ok = j == 0 ? hp : (j == 9 ? hn : true);
        if (ok) { cg[j] = *(const GAS v4u*)(pr + (ptrdiff_t)(j - 1) * NIN + C_CG); hg[j] = *(const GAS v4u*)(pr + (ptrdiff_t)(j - 1) * NIN + C_H); }
        else { cg[j] = (v4u){0u, 0u, 0u, 0u}; hg[j] = cg[j]; } }
#pragma unroll
    for (int i = 0; i < 8; ++i) bg[i] = *(const GAS v4u*)(pr + (size_t)i * NIN + C_BG);
    float w0[8], w1[8], w2[8];
#pragma unroll
    for (int q = 0; q < 2; ++q) { const f32x4 a = *(const f32x4*)(cw + ch + 4 * q), b = *(const f32x4*)(cw + WA + ch + 4 * q), c = *(const f32x4*)(cw + 2 * WA + ch + 4 * q);
#pragma unroll
        for (int k = 0; k < 4; ++k) { w0[4 * q + k] = a[k]; w1[4 * q + k] = b[k]; w2[4 * q + k] = c[k]; } }
    float zm[8], z0[8], zp[8];
#pragma unroll
    for (int w = 0; w < 4; ++w) { zm[2 * w] = bflo(cg[0][w]) * bflo(hg[0][w]); zm[2 * w + 1] = bfhi(cg[0][w]) * bfhi(hg[0][w]); z0[2 * w] = bflo(cg[1][w]) * bflo(hg[1][w]); z0[2 * w + 1] = bfhi(cg[1][w]) * bfhi(hg[1][w]); }
#pragma unroll
    for (int i = 0; i < 8; ++i) {
#pragma unroll
        for (int w = 0; w < 4; ++w) { zp[2 * w] = bflo(cg[i + 2][w]) * bflo(hg[i + 2][w]); zp[2 * w + 1] = bfhi(cg[i + 2][w]) * bfhi(hg[i + 2][w]); }
        unsigned ow[4];
#pragma unroll
        for (int w = 0; w < 4; ++w) {
            const float yl = w0[2 * w] * zm[2 * w] + w1[2 * w] * z0[2 * w] + w2[2 * w] * zp[2 * w], yh = w0[2 * w + 1] * zm[2 * w + 1] + w1[2 * w + 1] * z0[2 * w + 1] + w2[2 * w + 1] * zp[2 * w + 1];
            ow[w] = pk2(bflo(bg[i][w]) * yl, bfhi(bg[i][w]) * yh); }
        *(GAS v4u*)(OZ + (size_t)(row0 + i) * D + WA + ch) = (v4u){ow[0], ow[1], ow[2], ow[3]};
#pragma unroll
        for (int k = 0; k < 8; ++k) { zm[k] = z0[k]; z0[k] = zp[k]; }
    }
}
DI void phase_prep(Frame& F, const float* lbnd, int layer, const float* cw, int flags) {
    const bf16* P = (const bf16*)(F.ws + WS_P);
    const int gw = blockIdx.x * NWAVES + F.wave, NGW = F.G * NWAVES;
    LAS unsigned char* wl = F.lds + RING_OFF + F.wave * 16384;
    for (int tk = gw; tk < NKB * NHEAD; tk += NGW) prep_task(F, P, lbnd, layer, tk >> 4, tk & 15, wl, flags & 1024);
    if (!(flags & 2048)) for (int tk = gw; tk < (MR / 8) * 4; tk += NGW) conv_strip(F, cw, tk);
}
template <class GemmFn>
DI void phase_scan_gemm(Frame& F, int flags, const GemmFn& zb_gemm) {
    const int nsc = F.G >= 2 * SC_WGS ? SC_WGS : 0;
    if (nsc) {
        if ((int)blockIdx.x < nsc) { if (!(flags & 1)) scan_wg(F, (int)blockIdx.x); }
        else if (!(flags & 2)) zb_gemm(F.G - nsc, (int)blockIdx.x - nsc);
    } else {
        if (!(flags & 1)) for (int st = blockIdx.x; st < 64; st += F.G) { scan_wg(F, st); __syncthreads(); }
        if (!(flags & 2)) zb_gemm(F.G, (int)blockIdx.x);
    }
}
DI void phase_combine(Frame& F, const float* gn  , int nrows) {
    const bf16* P = (const bf16*)(F.ws + WS_P); bf16* OZ = (bf16*)(F.ws + WS_OAZB);
    const bf16* OF = (const bf16*)(F.ws + WS_OF); const bf16* OB = (const bf16*)(F.ws + WS_OB);
    const int gw = blockIdx.x * NWAVES + F.wave, NGW = F.G * NWAVES;
    const int vl = (F.lane & 15) * 8;
    const f32x4 g0 = *(const f32x4*)(gn + vl), g1 = *(const f32x4*)(gn + vl + 4);
    for (int row = gw; row < nrows; row += NGW) {
#pragma unroll
        for (int it = 0; it < 4; ++it) { const int ch = (it * 4 + (F.lane >> 4)) * DK + vl;
            const size_t off = (size_t)row * WA + ch;
            const v4u of4 = *(const GAS v4u*)(OF + off), ob4 = *(const GAS v4u*)(OB + off);
            f32x4 a = {bflo(of4[0]) + bflo(ob4[0]), bfhi(of4[0]) + bfhi(ob4[0]), bflo(of4[1]) + bflo(ob4[1]), bfhi(of4[1]) + bfhi(ob4[1])}, b = {bflo(of4[2]) + bflo(ob4[2]), bfhi(of4[2]) + bfhi(ob4[2]), bflo(of4[3]) + bflo(ob4[3]), bfhi(of4[3]) + bfhi(ob4[3])};
            const v4u gw4 = *(const GAS v4u*)(P + (size_t)row * NIN + C_G + ch);
            float ss = (a[0] * a[0] + a[1] * a[1]) + (a[2] * a[2] + a[3] * a[3]) + (b[0] * b[0] + b[1] * b[1]) + (b[2] * b[2] + b[3] * b[3]);
            ss += shfl_x(ss, 1, F.lane); ss += shfl_x(ss, 2, F.lane); ss += shfl_x(ss, 4, F.lane); ss += shfl_x(ss, 8, F.lane);
            const float rinv = 1.f / sqrtf(ss * (1.f / DK) + RMS_EPS);
            float gl[8];
#pragma unroll
            for (int w = 0; w < 4; ++w) { const float x0 = bflo(gw4[w]), x1 = bfhi(gw4[w]); gl[2 * w] = x0 * sigmoidf_(x0); gl[2 * w + 1] = x1 * sigmoidf_(x1); }
            a = a * rinv * g0; b = b * rinv * g1;
            v4u o; o.x = pk2(a[0] * gl[0], a[1] * gl[1]); o.y = pk2(a[2] * gl[2], a[3] * gl[3]); o.z = pk2(b[0] * gl[4], b[1] * gl[5]); o.w = pk2(b[2] * gl[6], b[3] * gl[7]);
            *(GAS v4u*)(OZ + (size_t)row * D + ch) = o; }
    }
}
constexpr int N_PHASES = 3 + 2 * 10;
struct Args { const float* in[17]; float* out; unsigned char* ws; int ph_lo, ph_hi, flags, pad; };
__global__ void __launch_bounds__(NWAVES * 64, 2) mk_fwd(Args args) {
    extern __shared__ __attribute__((aligned(16))) unsigned char lds[];
    Frame F;
    F.lds = (LAS unsigned char*)lds;
    F.MISC = (volatile LAS unsigned*)(F.lds + MISC_OFF);
    F.tid = threadIdx.x; F.lane = F.tid & 63; F.wave = __builtin_amdgcn_readfirstlane(F.tid >> 6);
    F.G = gridDim.x; F.ws = args.ws;
    F.ctl = (gu32*)(args.ws + WS_CTL);
    for (int u = F.tid; u < (LDS_BYTES - LDSCTL_OFF) / 4; u += NWAVES * 64) ((LAS unsigned*)(F.lds + LDSCTL_OFF))[u] = 0u;
    __syncthreads();
#if MK_SPLIT
#define GRID_BAR() do { } while (0)
#else
    XcdBarrier bar = xcd_barrier_post((unsigned*)(F.ctl + CW_BAR), F.MISC + 8);
#define GRID_BAR() xcd_barrier(bar)
#endif
    unsigned char* ws = args.ws; const CAS Args* ap = nullptr;
#define MODP ((const float*)(ws + WS_MOD))
    const int lo = args.ph_lo, hi = args.ph_hi; (void)lo; (void)hi;
#ifndef PH_MASK
#define PH_MASK 0xffff
#endif
#define EN(kind) (((PH_MASK) >> (kind)) & 1)
#ifndef DUP_MASK
#define DUP_MASK 0
#endif
#define REPS(kind) (1 + (((DUP_MASK) >> (kind)) & 1))
#ifndef RT_RANGE
#define RT_RANGE 0
#define PROBE_LO 0
#define PROBE_HI 0
#define PROBE_FLAGS 0
#endif
#if MK_SPLIT || RT_RANGE
#define IN(k) (lo <= (k) && (k) < hi)
#else
#define IN(k) true
#endif
#define REFRESH() do { int t_; asm volatile("v_mbcnt_lo_u32_b32 %0, -1, 0\n\tv_mbcnt_hi_u32_b32 %0, -1, %0" : "=v"(t_)); t_ += F.wave * 64;     F.tid = t_; F.lane = t_ & 63; ap = (const CAS Args*)__builtin_amdgcn_kernarg_segment_ptr(); asm volatile("" : "+s"(ap)); ws = ap->ws; F.ws = ws; { unsigned lb_ = (unsigned)(size_t)(LAS unsigned char*)lds; asm volatile("" : "+s"(lb_)); F.lds = (LAS unsigned char*)(size_t)lb_; } } while (0)
#define INP(k) (ap->in[k])
#define SEAM(k) do { if (IN(k) && IN((k) + 1)) GRID_BAR(); } while (0)

    for (int rep_ = 0; rep_ < REPS(0); ++rep_) if (EN(0) && IN(0)) { if (rep_) GRID_BAR(); REFRESH(); P0Args A{INP(1), INP(3), INP(4), INP(6), INP(9), INP(10), INP(11), INP(12), INP(13)}; phase0(F, A); } SEAM(0);
    for (int rep_ = 0; rep_ < REPS(1); ++rep_) if (EN(1) && IN(1)) { if (rep_) GRID_BAR(); REFRESH(); phase1(F, INP(5)); } SEAM(1);
#ifdef PROBE_EXTRA_BARRIERS
    for (int xb_ = 0; xb_ < PROBE_EXTRA_BARRIERS; ++xb_) GRID_BAR();
#endif
    for (int rep_ = 0; rep_ < REPS(2); ++rep_) if (EN(2) && IN(2)) { if (rep_) GRID_BAR(); REFRESH(); phase_modulate0(F, INP(0), INP(2)); } SEAM(2);

    for (int l = 0; l < 2; ++l) {
        const int pb = 3 + 10 * l;
        const bool last = (l == 1);
        const int Mrows = last ? ML : MR;
#define MODL (MODP + (size_t)l * 3 * NIN)
        for (int rep_ = 0; rep_ < REPS(3); ++rep_) if (EN(3) && IN(pb + 0)) { if (rep_) GRID_BAR(); REFRESH();
            pg8::Gemm g{(const pg8::bf16_t*)(ws + WS_U), (const pg8::bf16_t*)(ws + WS_WIN + l * SZ_WIN), MR, NIN, D, D}; pg8::StaticOrder S; S.init(MR, NIN, F.G, (int)blockIdx.x);
            pg8::EpiStoreBf16<0> E{(pg8::bf16_t*)(ws + WS_P), NIN, 0};
            pg8::gemm_phase<pg8::EpiStoreBf16<0>, pg8::StaticOrder, true, true>(F.lds + RING_OFF, g, S, E, F.tid);
            if (F.G == 256 && !(ap->flags & 32)) { P0Args A{INP(1), INP(3), INP(4), INP(6), INP(9), INP(10), INP(11), INP(12), INP(13)}; bg_convert(F, A, 192, l == 0 ? BG_S0 : BG_S4, l == 0 ? BG_S1 : BG_S5); }
        } SEAM(pb + 0);
        for (int rep_ = 0; rep_ < REPS(4); ++rep_) if (EN(4) && IN(pb + 1)) { if (rep_) GRID_BAR(); REFRESH(); phase_prep(F, INP(16), l, INP(7) + (size_t)l * 3 * WA, ap->flags); } SEAM(pb + 1);
        for (int rep_ = 0; rep_ < REPS(5); ++rep_) if (EN(5) && IN(pb + 2)) { if (rep_) GRID_BAR(); REFRESH();
            const int fl = ap->flags;
            auto zb_gemm = [&](int G2, int c2) {
                pg8::Gemm g{(const pg8::bf16_t*)(ws + WS_OAZB), (const pg8::bf16_t*)(ws + WS_WAB + l * SZ_WAB), Mrows, D, D, D / 2}; pg8::StaticOrder S; S.init(Mrows, D, G2, c2); S.kc0 = 1;
                pg8::EpiPartB E{(const pg8::bf16_t*)(ws + WS_P), (pg8::bf16_t*)(ws + WS_YPART)};
                pg8::gemm_phase<pg8::EpiPartB, pg8::StaticOrder, true, true>(F.lds + RING_OFF, g, S, E, F.tid); };
            phase_scan_gemm(F, fl, zb_gemm);
        } SEAM(pb + 2);
        for (int rep_ = 0; rep_ < REPS(6); ++rep_) if (EN(6) && IN(pb + 3)) { if (rep_) GRID_BAR(); REFRESH(); phase_combine(F, INP(8) + l * DK, Mrows); } SEAM(pb + 3);
        for (int rep_ = 0; rep_ < REPS(7); ++rep_) if (EN(7) && IN(pb + 4)) { if (rep_) GRID_BAR(); REFRESH();
            pg8::Gemm g{(const pg8::bf16_t*)(ws + WS_OAZB), (const pg8::bf16_t*)(ws + WS_WAB + l * SZ_WAB), Mrows, D, D, D / 2}; pg8::StaticOrder S; S.init(Mrows, D, F.G, (int)blockIdx.x);
            pg8::EpiMergeA E{(const pg8::bf16_t*)(ws + WS_P), (const pg8::bf16_t*)(ws + WS_YPART), (pg8::bf16_t*)(ws + WS_YPRE)};
            pg8::gemm_phase<pg8::EpiMergeA, pg8::StaticOrder, true, true>(F.lds + RING_OFF, g, S, E, F.tid);
            if (F.G == 256 && l == 0 && !(ap->flags & 32)) { P0Args A{INP(1), INP(3), INP(4), INP(6), INP(9), INP(10), INP(11), INP(12), INP(13)}; bg_convert(F, A, 32, BG_S2, BG_S3); }
        } SEAM(pb + 4);
        for (int rep_ = 0; rep_ < REPS(8); ++rep_) if (EN(8) && IN(pb + 5)) { if (rep_) GRID_BAR(); REFRESH();
            { pg8::Gemm g{(const pg8::bf16_t*)(ws + WS_YPRE), (const pg8::bf16_t*)(ws + WS_WO + l * SZ_WO), ML, D, D, D}; pg8::StaticOrder S; S.init(ML, D, F.G, (int)blockIdx.x);
              if (l == 0) { const float* xl = INP(0); pg8::EpiRes E{xl, xl, MODL, 2 * D, (float*)(ws + WS_R), ALPHA};
                  pg8::gemm_phase<pg8::EpiRes, pg8::StaticOrder, true, true>(F.lds + RING_OFF, g, S, E, F.tid); }
              else {
                  pg8::EpiResLn E{(const float*)(ws + WS_ST) + 2 * MR, INP(14) + (size_t)1 * D, INP(15) + (size_t)1 * D, MODL, 2 * D, (float*)(ws + WS_R), ALPHA};
                  pg8::gemm_phase<pg8::EpiResLn, pg8::StaticOrder, true, true>(F.lds + RING_OFF, g, S, E, F.tid); } }
            if (!last) { pg8::Gemm g{(const pg8::bf16_t*)(ws + WS_YPRE) + (size_t)ML * D, (const pg8::bf16_t*)(ws + WS_WO + l * SZ_WO), MC, D, D, D / 8}; pg8::SplitOrder S; S.init(F.G, (int)blockIdx.x);
              pg8::EpiSlab E{(float*)(ws + WS_SLAB), (ap->flags & 512) ? 1 : 0};
              pg8::gemm_phase<pg8::EpiSlab, pg8::SplitOrder, true, true>(F.lds + RING_OFF, g, S, E, F.tid); }
        } SEAM(pb + 5);
        for (int rep_ = 0; rep_ < REPS(9); ++rep_) if (EN(9) && IN(pb + 6)) { if (rep_) GRID_BAR(); REFRESH();
            if (!last) phase_ln<true, true>(F, (const float*)(ws + WS_R), INP(14) + (size_t)(l * 2 + 0) * D, INP(15) + (size_t)(l * 2 + 0) * D, (float*)(ws + WS_X1), ML  , (float*)(ws + WS_ST), MR, MODL, 3 * D, 4 * D, (const float*)(ws + WS_SLAB), INP(2), MODL + 2 * NIN + 2 * D);
            else phase_ln<true, false>(F, (const float*)(ws + WS_R), INP(14) + (size_t)(l * 2 + 0) * D, INP(15) + (size_t)(l * 2 + 0) * D, (float*)(ws + WS_X1), 0x7fffffff, (float*)(ws + WS_ST), ML, MODL, 3 * D, 4 * D, nullptr, nullptr, nullptr);
        } SEAM(pb + 6);
        for (int rep_ = 0; rep_ < REPS(10); ++rep_) if (EN(10) && IN(pb + 7)) { if (rep_) GRID_BAR(); REFRESH();
            pg8::Gemm g{(const pg8::bf16_t*)(ws + WS_U), (const pg8::bf16_t*)(ws + WS_WUP + l * SZ_WUP), Mrows, DFF, D, (ap->flags & 16) ? D / 4 : D}; pg8::StaticOrder S; S.init(Mrows, DFF, F.G, (int)blockIdx.x); if (ap->flags & 4) S.bmask = 0; if (ap->flags & 8) S.amask = 0;
            if (ap->flags & 128) { S.init(Mrows, DFF, F.G / 2, (int)blockIdx.x >> 1); if (blockIdx.x & 1) S.nwg = 0; }
            pg8::EpiStoreBf16<1> E{(pg8::bf16_t*)(ws + WS_H), DFF, (ap->flags & 64) ? 1 : 0};
            pg8::gemm_phase<pg8::EpiStoreBf16<1>, pg8::StaticOrder, true, true>(F.lds + RING_OFF, g, S, E, F.tid);
            if (F.G == 256 && l == 0 && !(ap->flags & 32)) { P0Args A{INP(1), INP(3), INP(4), INP(6), INP(9), INP(10), INP(11), INP(12), INP(13)}; bg_convert(F, A, 128, BG_S3, BG_S4); }
        } SEAM(pb + 7);
        for (int rep_ = 0; rep_ < REPS(11); ++rep_) if (EN(11) && IN(pb + 8)) { if (rep_) GRID_BAR(); REFRESH();
            { pg8::Gemm g{(const pg8::bf16_t*)(ws + WS_H), (const pg8::bf16_t*)(ws + WS_WDN + l * SZ_WDN), ML, D, DFF, DFF}; pg8::StaticOrder S; S.init(ML, D, F.G, (int)blockIdx.x);
              pg8::EpiResLn E{(const float*)(ws + WS_ST), INP(14) + (size_t)(l * 2 + 0) * D, INP(15) + (size_t)(l * 2 + 0) * D, MODL, 5 * D, (float*)(ws + WS_R), ALPHA};
              pg8::gemm_phase<pg8::EpiResLn, pg8::StaticOrder, true, true>(F.lds + RING_OFF, g, S, E, F.tid); }
            if (!last && !(ap->flags & 256)) { pg8::Gemm g{(const pg8::bf16_t*)(ws + WS_H) + (size_t)ML * DFF, (const pg8::bf16_t*)(ws + WS_WDN + l * SZ_WDN), MC, D, DFF, DFF / 8}; pg8::SplitOrder S; S.init(F.G, (int)blockIdx.x);
              pg8::EpiSlab E{(float*)(ws + WS_SLAB), (ap->flags & 512) ? 1 : 0};
              pg8::gemm_phase<pg8::EpiSlab, pg8::SplitOrder, true, true>(F.lds + RING_OFF, g, S, E, F.tid); }
        } SEAM(pb + 8);
        for (int rep_ = 0; rep_ < REPS(12); ++rep_) if (EN(12) && IN(pb + 9)) { if (rep_) GRID_BAR(); REFRESH();
            if (!last) phase_ln<true, true>(F, (const float*)(ws + WS_R), INP(14) + (size_t)(l * 2 + 1) * D, INP(15) + (size_t)(l * 2 + 1) * D, (float*)(ws + WS_X2), 0x7fffffff  , (float*)(ws + WS_ST) + 2 * MR, MR, MODP + (size_t)(l + 1) * 3 * NIN, 0, D, (const float*)(ws + WS_SLAB), (const float*)(ws + WS_X1) + (size_t)ML * D, MODL + 2 * NIN + 5 * D);
            else phase_ln<false, false>(F, (const float*)(ws + WS_R), INP(14) + (size_t)(l * 2 + 1) * D, INP(15) + (size_t)(l * 2 + 1) * D, ap->out, 0, nullptr, ML, nullptr, 0, 0, nullptr, nullptr, nullptr);
        }
        if (!last) SEAM(pb + 9);
    }
#undef IN
#undef SEAM
}

extern "C" void kernel_launch(void* const* d_in, const int* in_sizes, int n_in, void* d_out, int out_size, void* d_ws, size_t ws_size, hipStream_t stream) {
    static int grid = 0;
    if (grid == 0) {
        if (n_in != 17 || in_sizes[0] != ML * D || out_size != ML * D || ws_size < WS_END) {
            fprintf(stderr, "kernel_launch: unexpected shapes (n_in %d, in0 %d, out %d, ws %zu < %zu); nothing launched\n", n_in, n_in > 0 ? in_sizes[0] : -1, out_size, ws_size, (size_t)WS_END); grid = -1; return; }
        int dev = 0, cus = 0, per_cu = 0;
        if (hipGetDevice(&dev) != hipSuccess || hipDeviceGetAttribute(&cus, hipDeviceAttributeMultiprocessorCount, dev) != hipSuccess) { fprintf(stderr, "kernel_launch: device query failed\n"); grid = -1; return; }
        if (hipFuncSetAttribute((const void*)mk_fwd, hipFuncAttributeMaxDynamicSharedMemorySize, LDS_BYTES) != hipSuccess) { fprintf(stderr, "kernel_launch: hipFuncSetAttribute failed\n"); grid = -1; return; }
        if (hipOccupancyMaxActiveBlocksPerMultiprocessor(&per_cu, (const void*)mk_fwd, NWAVES * 64, LDS_BYTES) != hipSuccess || per_cu < 1)
            fprintf(stderr, "kernel_launch: note: occupancy query reports %d workgroups per CU\n", per_cu);
        (void)hipGetLastError();
        grid = cus;
    }
    if (grid < 0) return;
    if (hipMemsetAsync((char*)d_ws + WS_CTL, 0, CTL_ZERO_BYTES, stream) != hipSuccess) { fprintf(stderr, "kernel_launch: memset failed\n"); return; }
    Args a{};
    for (int i = 0; i < 17; ++i) a.in[i] = (const float*)d_in[i];
    a.out = (float*)d_out; a.ws = (unsigned char*)d_ws;
#if MK_SPLIT
    for (int ph = 0; ph < N_PHASES; ++ph) { a.ph_lo = ph; a.ph_hi = ph + 1; hipLaunchKernelGGL(mk_fwd, dim3(grid), dim3(NWAVES * 64), LDS_BYTES, stream, a); }
#else
    a.ph_lo = 0; a.ph_hi = N_PHASES;
    hipLaunchKernelGGL(mk_fwd, dim3(grid), dim3(NWAVES * 64), LDS_BYTES, stream, a);
#if RT_RANGE
    for (int l = 0; l < 2; ++l) { (void)hipMemsetAsync((char*)d_ws + WS_CTL, 0, CTL_ZERO_BYTES, stream); a.ph_lo = 3 + 10 * l + PROBE_LO; a.ph_hi = 3 + 10 * l + PROBE_HI; a.flags = PROBE_FLAGS; hipLaunchKernelGGL(mk_fwd, dim3(grid), dim3(NWAVES * 64), LDS_BYTES, stream, a); }
#endif
#endif
    const hipError_t le = hipPeekAtLastError();
    if (le != hipSuccess) fprintf(stderr, "kernel_launch: launch failed: %s\n", hipGetErrorName(le));
}
```
